# Optimizing an MI355X kernel written in HIP

```python
import math
import jax
import jax.numpy as jnp
from jax import lax
import numpy as np

D_MODEL = 2048
BATCH = 2
SEQ = 16384
DEPTH = 1

N_MEM = 256
MIX_WIDTH = D_MODEL
GLA_WIDTH = MIX_WIDTH // 2
DIFF_WIDTH = MIX_WIDTH // 4
MEM_WIDTH = MIX_WIDTH // 4

GLA_HEADS = 4
GLA_DV = GLA_WIDTH // GLA_HEADS
GLA_DK = GLA_DV // 2
GLA_LOWRANK = 16
GLA_TAU = 16.0
GLA_CHUNK = 64
GLA_NORM_EPS = 1e-6

DIFF_HEADS = 4
DIFF_DV = DIFF_WIDTH // DIFF_HEADS
DIFF_DQK = DIFF_DV // 2
DIFF_NORM_EPS = 1e-5
Q_BLOCK = 128

MEM_HEADS = 4
MEM_DH = MEM_WIDTH // MEM_HEADS

ROPE_THETA = 500000.0
ROT_DIM = DIFF_DQK // 4
LN_EPS = 1e-5
DEEPNORM_ALPHA = (2.0 * DEPTH) ** 0.25
DEEPNORM_BETA = (8.0 * DEPTH) ** -0.25

IN_SIZES = (
    GLA_HEADS * GLA_DK,
    GLA_HEADS * GLA_DK,
    GLA_WIDTH,
    GLA_WIDTH,
    GLA_LOWRANK,
    DIFF_WIDTH,
    DIFF_WIDTH,
    DIFF_WIDTH,
    DIFF_WIDTH,
    MEM_WIDTH,
    MEM_WIDTH,
)
IN_WIDTH = int(sum(IN_SIZES))
IN_SPLITS = tuple(int(s) for s in np.cumsum(IN_SIZES)[:-1])

kernel_name = 'hybrid_gla_diffattn_memxattn_deepnorm'


def _lambda_init(layer):
    return 0.8 - 0.6 * math.exp(-0.3 * layer)


def _layernorm(x, g, b):
    xf = x.astype(jnp.float32)
    mu = jnp.mean(xf, axis=-1, keepdims=True)
    var = jnp.mean(jnp.square(xf - mu), axis=-1, keepdims=True)
    y = (xf - mu) * lax.rsqrt(var + LN_EPS) * g.astype(jnp.float32) + b.astype(jnp.float32)
    return y.astype(x.dtype)


def _rmsnorm(x, g, eps):
    xf = x.astype(jnp.float32)
    y = xf * lax.rsqrt(jnp.mean(xf * xf, axis=-1, keepdims=True) + eps) * g.astype(jnp.float32)
    return y.astype(x.dtype)


def _rotary_tables(positions):
    half = jnp.arange(0, ROT_DIM, 2, dtype=jnp.float32) / ROT_DIM
    inv_freq = jnp.power(jnp.float32(ROPE_THETA), -half)
    ang = positions.astype(jnp.float32)[..., None] * inv_freq
    return jnp.cos(ang)[:, :, None, :], jnp.sin(ang)[:, :, None, :]


def _partial_rotary(x, cos, sin):
    half = ROT_DIM // 2
    x1 = x[..., :half].astype(jnp.float32)
    x2 = x[..., half:ROT_DIM].astype(jnp.float32)
    r1 = (x1 * cos - x2 * sin).astype(x.dtype)
    r2 = (x2 * cos + x1 * sin).astype(x.dtype)
    return jnp.concatenate([r1, r2, x[..., ROT_DIM:]], axis=-1)


def _gla_chunked(q, k, v, log_a):
    B, S, H, Dk = q.shape
    Dv = v.shape[-1]
    C = GLA_CHUNK
    nc = S // C

    def chunked(t):
        return t.astype(jnp.float32).reshape(B, nc, C, H, t.shape[-1]).transpose(1, 0, 3, 2, 4)

    qc = chunked(q * (GLA_DK ** -0.5))
    kc = chunked(k)
    vc = chunked(v)
    bc = lax.cumsum(chunked(log_a), axis=3)
    causal = jnp.tril(jnp.ones((C, C), dtype=bool))

    def step(state, inp):
        qi, ki, vi, bi = inp
        o_inter = jnp.einsum('bhck,bhkv->bhcv', qi * jnp.exp(bi), state)
        rel = bi[:, :, :, None, :] - bi[:, :, None, :, :]
        decay = jnp.exp(jnp.where(causal[:, :, None], rel, -jnp.inf))
        scores = jnp.einsum('bhik,bhjk,bhijk->bhij', qi, ki, decay)
        o_intra = jnp.einsum('bhij,bhjv->bhiv', scores, vi)
        b_last = bi[:, :, -1:, :]
        k_dec = ki * jnp.exp(b_last - bi)
        new_state = state * jnp.exp(b_last[:, :, 0, :])[..., None] + jnp.einsum('bhck,bhcv->bhkv', k_dec, vi)
        return new_state, o_inter + o_intra

    state0 = jnp.zeros((B, H, Dk, Dv), jnp.float32)
    _, o = lax.scan(step, state0, (qc, kc, vc, bc))
    return o.transpose(1, 0, 3, 2, 4).reshape(B, S, H, Dv).astype(v.dtype)


def _diff_attention(q, k, v, lam):
    B, S, H, _, Dqk = q.shape
    Dv = v.shape[-1]
    nb = S // Q_BLOCK
    qb = (q * (Dqk ** -0.5)).reshape(B, nb, Q_BLOCK, H, 2, Dqk).transpose(1, 0, 2, 3, 4, 5)
    key_pos = jnp.arange(S)

    def block(args):
        qi, i = args
        s = jnp.einsum('bqhcd,bkhcd->bhcqk', qi, k, preferred_element_type=jnp.float32)
        q_pos = i * Q_BLOCK + jnp.arange(Q_BLOCK)
        mask = key_pos[None, :] <= q_pos[:, None]
        p = jax.nn.softmax(jnp.where(mask, s, -jnp.inf), axis=-1)
        w = p[:, :, 0] - lam * p[:, :, 1]
        return jnp.einsum('bhqk,bkhd->bqhd', w.astype(v.dtype), v)

    out = lax.map(block, (qb, jnp.arange(nb)))
    return out.transpose(1, 0, 2, 3, 4).reshape(B, S, H, Dv)


def _memory_attention(q, mk, mv):
    s = jnp.einsum('bshd,bmhd->bhsm', q * (MEM_DH ** -0.5), mk, preferred_element_type=jnp.float32)
    p = jax.nn.softmax(s, axis=-1)
    return jnp.einsum('bhsm,bmhd->bshd', p.astype(mv.dtype), mv)


def setup_inputs(seed: int = 0) -> dict:
    key = jax.random.key(seed)
    ks = jax.random.split(key, 16)
    f32 = jnp.float32
    x = jax.random.normal(ks[0], (BATCH, SEQ, D_MODEL), f32)
    mem = jax.random.normal(ks[1], (BATCH, N_MEM, D_MODEL), f32)
    offset = jax.random.randint(ks[2], (BATCH, 1), 0, 4096, dtype=jnp.int32)
    positions = offset + jnp.arange(SEQ, dtype=jnp.int32)[None, :]
    w_in = jax.random.normal(ks[3], (DEPTH, D_MODEL, IN_WIDTH), f32) * D_MODEL ** -0.5
    w_gk_up = jax.random.normal(ks[4], (DEPTH, GLA_LOWRANK, GLA_HEADS * GLA_DK), f32) * GLA_LOWRANK ** -0.5
    b_gk_up = 0.1 * jax.random.normal(ks[5], (DEPTH, GLA_HEADS * GLA_DK), f32)
    gla_norm_g = 1.0 + 0.02 * jax.random.normal(ks[6], (DEPTH, GLA_DV), f32)
    lambda_q1 = 0.1 * jax.random.normal(ks[7], (DEPTH, DIFF_DQK), f32)
    lambda_k1 = 0.1 * jax.random.normal(ks[8], (DEPTH, DIFF_DQK), f32)
    lambda_q2 = 0.1 * jax.random.normal(ks[9], (DEPTH, DIFF_DQK), f32)
    lambda_k2 = 0.1 * jax.random.normal(ks[10], (DEPTH, DIFF_DQK), f32)
    diff_norm_g = 1.0 + 0.02 * jax.random.normal(ks[11], (DEPTH, DIFF_DV), f32)
    w_mem_kv = jax.random.normal(ks[12], (DEPTH, D_MODEL, 2 * MEM_WIDTH), f32) * D_MODEL ** -0.5
    w_out = jax.random.normal(ks[13], (DEPTH, MIX_WIDTH, D_MODEL), f32) * (MIX_WIDTH ** -0.5 * DEEPNORM_BETA)
    ln_g = 1.0 + 0.02 * jax.random.normal(ks[14], (DEPTH, D_MODEL), f32)
    ln_b = 0.02 * jax.random.normal(ks[15], (DEPTH, D_MODEL), f32)
    return {'x': x, 'mem': mem, 'positions': positions, 'w_in': w_in,
            'w_gk_up': w_gk_up, 'b_gk_up': b_gk_up, 'gla_norm_g': gla_norm_g,
            'lambda_q1': lambda_q1, 'lambda_k1': lambda_k1,
            'lambda_q2': lambda_q2, 'lambda_k2': lambda_k2,
            'diff_norm_g': diff_norm_g, 'w_mem_kv': w_mem_kv, 'w_out': w_out,
            'ln_g': ln_g, 'ln_b': ln_b}


def reference(x, mem, positions, w_in, w_gk_up, b_gk_up, gla_norm_g,
              lambda_q1, lambda_k1, lambda_q2, lambda_k2, diff_norm_g,
              w_mem_kv, w_out, ln_g, ln_b):
    B, S, _ = x.shape
    M = mem.shape[1]
    f32 = jnp.float32
    cos, sin = _rotary_tables(positions)
    h = x
    for l in range(DEPTH):
        proj = jnp.einsum('bsd,de->bse', h, w_in[l])
        (g_q, g_k, g_v, g_g, g_lr, d_q, d_k, d_v, d_g, m_q, m_g) = jnp.split(proj, IN_SPLITS, axis=-1)

        gk_logit = (jnp.einsum('bsr,rk->bsk', g_lr, w_gk_up[l]) + b_gk_up[l]).astype(f32)
        log_a = jax.nn.log_sigmoid(gk_logit) / GLA_TAU
        gla = _gla_chunked(g_q.reshape(B, S, GLA_HEADS, GLA_DK),
                           g_k.reshape(B, S, GLA_HEADS, GLA_DK),
                           g_v.reshape(B, S, GLA_HEADS, GLA_DV),
                           log_a.reshape(B, S, GLA_HEADS, GLA_DK))
        gla = _rmsnorm(gla, gla_norm_g[l], GLA_NORM_EPS).reshape(B, S, GLA_WIDTH) * jax.nn.silu(g_g)

        dq = _partial_rotary(d_q.reshape(B, S, 2 * DIFF_HEADS, DIFF_DQK), cos, sin).reshape(B, S, DIFF_HEADS, 2, DIFF_DQK)
        dk = _partial_rotary(d_k.reshape(B, S, 2 * DIFF_HEADS, DIFF_DQK), cos, sin).reshape(B, S, DIFF_HEADS, 2, DIFF_DQK)
        lam_init = _lambda_init(l)
        lam = (jnp.exp(jnp.sum(lambda_q1[l].astype(f32) * lambda_k1[l].astype(f32)))
               - jnp.exp(jnp.sum(lambda_q2[l].astype(f32) * lambda_k2[l].astype(f32))) + lam_init)
        diff = _diff_attention(dq, dk, d_v.reshape(B, S, DIFF_HEADS, DIFF_DV), lam)
        diff = (_rmsnorm(diff, diff_norm_g[l], DIFF_NORM_EPS) * (1.0 - lam_init)).reshape(B, S, DIFF_WIDTH) * jax.nn.silu(d_g)

        mkv = jnp.einsum('bmd,de->bme', mem, w_mem_kv[l])
        m_k, m_v = jnp.split(mkv, 2, axis=-1)
        xat = _memory_attention(m_q.reshape(B, S, MEM_HEADS, MEM_DH),
                                m_k.reshape(B, M, MEM_HEADS, MEM_DH),
                                m_v.reshape(B, M, MEM_HEADS, MEM_DH))
        xat = xat.reshape(B, S, MEM_WIDTH) * jax.nn.silu(m_g)

        mix = jnp.concatenate([gla, diff, xat], axis=-1)
        out = jnp.einsum('bse,ed->bsd', mix, w_out[l])
        h = _layernorm(DEEPNORM_ALPHA * h + out, ln_g[l], ln_b[l])
    return h
```

```cpp
#include <hip/hip_runtime.h>
#include <hip/hip_bf16.h>
#include <hip/hip_cooperative_groups.h>
#include <cstdio>
#include <cstdint>
#include <cmath>
namespace cg = cooperative_groups;
namespace pg8 {
#define PG8_LAS __attribute__((address_space(3)))
typedef unsigned short bf16_t;
typedef short bf16x8 __attribute__((ext_vector_type(8)));
typedef float f32x4 __attribute__((ext_vector_type(4)));
typedef unsigned u32x4 __attribute__((ext_vector_type(4)));
constexpr int BM = 256, BK = 64, HALF = 128, HTB = HALF * BK * 2  , STAGE_BYTES = 8 * HTB, NXCD = 8, WGM = 2;

__host__ __device__ __forceinline__ int lds_byte(int r, int c) { const int st = (r >> 4) * 2 + (c >> 5), rr = r & 15, cc = c & 31, ob = rr * 64 + cc * 2; return st * 1024 + (ob ^ (((ob >> 9) & 1) << 5)); }
__host__ __device__ __forceinline__ void stage_rc(int b, int& R, int& C) { const int st = b / 1024, sb = b % 1024, swz = sb ^ (((sb >> 9) & 1) << 5); R = (st >> 1) * 16 + swz / 64; C = (st & 1) * 32 + (swz % 64) / 2; }
__host__ __device__ __forceinline__ int perm32(int rho) { const int n = rho >> 4, i = rho & 15; return 8 * (i >> 2) + 4 * n + (i & 3); }

struct Unit { int pm, pn; };
struct Gemm { const bf16_t* A; const bf16_t* Bt; int M, N, K; };

struct StaticOrder {
    int nM, nN, nwg, G, c;
    __host__ __device__ void init(int M, int N, int G_, int c_) { nM = M / BM; nN = N / BM; nwg = nM * nN; G = G_; c = c_; }
    __host__ __device__ bool next(int i, Unit& u) const {
        const long L = (long)i * G + c; if (L >= nwg) return false;
        int wgid = (int)L; { const int q = nwg / NXCD, r = nwg % NXCD, xcd = wgid % NXCD, off = wgid / NXCD; wgid = (xcd < r ? xcd * (q + 1) : r * (q + 1) + (xcd - r) * q) + off; }
        const int nig = WGM * nN, gid = wgid / nig, fm = gid * WGM, gsz = (nM - fm) < WGM ? (nM - fm) : WGM;
        u.pm = fm + ((wgid % nig) % gsz); u.pn = (wgid % nig) / gsz; return true;
    }
    __device__ __forceinline__ void a_ready(const Unit&) const {}
    __device__ __forceinline__ void done(const Unit&) const {}
};

__device__ __forceinline__ unsigned cvt_pk_bf16(float lo, float hi) { unsigned r; asm volatile("v_cvt_pk_bf16_f32 %0, %1, %2" : "=v"(r) : "v"(lo), "v"(hi)); return r; }
typedef float f32x2 __attribute__((ext_vector_type(2)));
struct EpiProj {
    static constexpr bool PERM = true, AFTER_DRAIN = false;
    bf16_t* O; const float* cs;
    __device__ __forceinline__ void operator()(const f32x4 (&acc)[2][2][4][2], const Unit& u, int wr, int wc, int fr, int fq) const {
        const int pn = u.pn;
        const int row0 = u.pm * BM + wr * 64 + fr;
        const int col0 = pn * BM + wc * 32 + 8 * fq;
        float sc = 1.f; bool rotm = false;
        if (pn < 2) sc = 0.08838834764831845f;
        else if (pn == 12 || pn == 13) { rotm = true; sc = 0.125f * 1.4426950408889634f; }
        else if (pn == 14 || pn == 15) { rotm = true; }
        else if (pn == 20 || pn == 21) sc = 0.08838834764831845f * 1.4426950408889634f;
        const bool rot = rotm && ((wc & 1) == 0);
#pragma unroll
        for (int ai = 0; ai < 2; ++ai)
#pragma unroll
            for (int m = 0; m < 4; ++m) {
                const int row = row0 + ai * HALF + m * 16;
                bf16_t* rowp = O + (size_t)row * 6144 + col0;
                f32x4 c0 = {1.f, 1.f, 1.f, 1.f}, c1 = c0, s0 = {0.f, 0.f, 0.f, 0.f}, s1 = s0;
                if (rot) { const f32x4* cp = (const f32x4*)(cs + (size_t)row * 16); c0 = cp[0]; c1 = cp[1]; s0 = cp[2]; s1 = cp[3]; }
#pragma unroll
                for (int bj = 0; bj < 2; ++bj) {
                    f32x4 v0 = acc[ai][bj][m][0], v1 = acc[ai][bj][m][1];
                    if (rot) {
                        f32x4 p0, p1;
#pragma unroll
                        for (int e = 0; e < 4; ++e) { p0[e] = __shfl_xor(v0[e], 16); p1[e] = __shfl_xor(v1[e], 16); }
                        if (fq == 0) { v0 = v0 * c0 - p0 * s0; v1 = v1 * c1 - p1 * s1; }
                        else if (fq == 1) { v0 = v0 * c0 + p0 * s0; v1 = v1 * c1 + p1 * s1; }
                    }
                    v0 = v0 * sc; v1 = v1 * sc;
                    u32x4 w; w.x = cvt_pk_bf16(v0[0], v0[1]); w.y = cvt_pk_bf16(v0[2], v0[3]); w.z = cvt_pk_bf16(v1[0], v1[1]); w.w = cvt_pk_bf16(v1[2], v1[3]);
                    *(u32x4*)(rowp + bj * HALF) = w;
                }
            }
    }
};
struct EpiMkv {
    static constexpr bool PERM = true, AFTER_DRAIN = false;
    bf16_t* mk; bf16_t* mvT;
    __device__ __forceinline__ void operator()(const f32x4 (&acc)[2][2][4][2], const Unit& u, int wr, int wc, int fr, int fq) const {
        const int row0 = u.pm * BM + wr * 64 + fr;
        const int col0 = u.pn * BM + wc * 32 + 8 * fq;
#pragma unroll
        for (int ai = 0; ai < 2; ++ai)
#pragma unroll
            for (int m = 0; m < 4; ++m) {
                const int row = row0 + ai * HALF + m * 16; const int b = row >> 8, mm = row & 255;
#pragma unroll
                for (int bj = 0; bj < 2; ++bj) {
                    const f32x4 v0 = acc[ai][bj][m][0], v1 = acc[ai][bj][m][1];
                    const int col = col0 + bj * HALF;
                    u32x4 w; w.x = cvt_pk_bf16(v0[0], v0[1]); w.y = cvt_pk_bf16(v0[2], v0[3]); w.z = cvt_pk_bf16(v1[0], v1[1]); w.w = cvt_pk_bf16(v1[2], v1[3]);
                    if (col < 512) { *(u32x4*)(mk + (size_t)row * 512 + col) = w; }
                    else {
                        const int c2 = col - 512, hh = c2 >> 7, d = c2 & 127;
                        bf16_t* p = mvT + ((size_t)((b * 4 + hh) * 128 + d)) * 256 + mm;
                        p[0 * 256] = (bf16_t)(w.x & 0xffffu); p[1 * 256] = (bf16_t)(w.x >> 16);
                        p[2 * 256] = (bf16_t)(w.y & 0xffffu); p[3 * 256] = (bf16_t)(w.y >> 16);
                        p[4 * 256] = (bf16_t)(w.z & 0xffffu); p[5 * 256] = (bf16_t)(w.z >> 16);
                        p[6 * 256] = (bf16_t)(w.w & 0xffffu); p[7 * 256] = (bf16_t)(w.w >> 16);
                    }
                }
            }
    }
};
struct EpiY {
    static constexpr bool PERM = false, AFTER_DRAIN = false;
    const float* x; float* out; float alpha;
    __device__ __forceinline__ void operator()(const f32x4 (&acc)[2][2][4][2], const Unit& u, int wr, int wc, int fr, int fq) const {
        const int row0 = u.pm * BM + wr * 64 + fr;
        const int col0 = u.pn * BM + wc * 32 + 4 * fq;
#pragma unroll
        for (int ai = 0; ai < 2; ++ai)
#pragma unroll
            for (int m = 0; m < 4; ++m) {
                const size_t off = (size_t)(row0 + ai * HALF + m * 16) * 2048 + col0;
#pragma unroll
                for (int bj = 0; bj < 2; ++bj)
#pragma unroll
                    for (int n = 0; n < 2; ++n) {
                        const f32x4 xv = *(const f32x4*)(x + off + bj * HALF + n * 16);
                        *(f32x4*)(out + off + bj * HALF + n * 16) = xv * alpha + acc[ai][bj][m][n];
                    }
            }
    }
};
struct EpiOutB {
    static constexpr bool PERM = true, AFTER_DRAIN = false;
    bf16_t* O;
    __device__ __forceinline__ void operator()(const f32x4 (&acc)[2][2][4][2], const Unit& u, int wr, int wc, int fr, int fq) const {
        const int row0 = u.pm * BM + wr * 64 + fr;
        const int col0 = u.pn * BM + wc * 32 + 8 * fq;
#pragma unroll
        for (int ai = 0; ai < 2; ++ai)
#pragma unroll
            for (int m = 0; m < 4; ++m) {
                bf16_t* rowp = O + (size_t)(row0 + ai * HALF + m * 16) * 2048 + col0;
#pragma unroll
                for (int bj = 0; bj < 2; ++bj) {
                    const f32x4 v0 = acc[ai][bj][m][0], v1 = acc[ai][bj][m][1];
                    u32x4 w; w.x = cvt_pk_bf16(v0[0], v0[1]); w.y = cvt_pk_bf16(v0[2], v0[3]); w.z = cvt_pk_bf16(v1[0], v1[1]); w.w = cvt_pk_bf16(v1[2], v1[3]);
                    *(u32x4*)(rowp + bj * HALF) = w;
                }
            }
    }
};
template <class Epi, class Sched, bool ALIGN_EPI = false, bool SP2 = false>
__device__ __forceinline__ void gemm_phase(PG8_LAS unsigned char* lds, const Gemm g, const Sched& S, const Epi& E, const int tid) {
    const int wid = __builtin_amdgcn_readfirstlane(tid >> 6), lane = tid & 63, wr = wid >> 2, wc = wid & 3, fr = lane & 15, fq = lane >> 4;
    const int K = g.K, nt = K / BK;
    unsigned voffA[2], voffB[2];
#pragma unroll
    for (int i = 0; i < 2; ++i) { int R, C; stage_rc(tid * 16 + i * 8192, R, C); const int Rb = Epi::PERM ? ((R & ~31) + perm32(R & 31)) : R;
        voffA[i] = (unsigned)(R * K + C) * 2u; voffB[i] = (unsigned)(Rb * K + C) * 2u; }
    const size_t kstep = (size_t)(BK * 2);
    const size_t hstep = (size_t)HALF * K * 2;
    const size_t tstep = 2 * hstep;
    const unsigned ldsw = (unsigned)wid * 1024u;
    const int aoff = lds_byte(wr * 64 + fr, fq * 8), boff = lds_byte(wc * 32 + fr, fq * 8);
#define PG8_SA(b, h) (((b) * 2 + (h)) * HTB)
#define PG8_SB(b, h) ((4 + (b) * 2 + (h)) * HTB)
#define PG8_STAGE(bufoff, gbase, voff) do { _Pragma("unroll") for (int _i = 0; _i < 2; ++_i) \
        __builtin_amdgcn_global_load_lds((const unsigned*)((const char*)(gbase) + (voff)[_i]), (PG8_LAS unsigned*)(lds + (bufoff) + ldsw + _i * 8192), 16, 0, 0); } while (0)
#define PG8_LDA(dst, b, h) do { _Pragma("unroll") for (int m = 0; m < 4; ++m) _Pragma("unroll") for (int k = 0; k < 2; ++k) dst[m][k] = *(const PG8_LAS bf16x8*)(lds + PG8_SA(b, h) + aoff + m * 2048 + k * 1024); } while (0)
#define PG8_LDB(dst, b, h) do { _Pragma("unroll") for (int n = 0; n < 2; ++n) _Pragma("unroll") for (int k = 0; k < 2; ++k) dst[n][k] = *(const PG8_LAS bf16x8*)(lds + PG8_SB(b, h) + boff + n * 2048 + k * 1024); } while (0)
#define PG8_MMA(ai, bj, At, Bt) do { __builtin_amdgcn_s_setprio(1); _Pragma("unroll") for (int m = 0; m < 4; ++m) _Pragma("unroll") for (int n = 0; n < 2; ++n) _Pragma("unroll") for (int k = 0; k < 2; ++k) \
        acc[ai][bj][m][n] = __builtin_amdgcn_mfma_f32_16x16x32_bf16(Bt[n][k], At[m][k], acc[ai][bj][m][n], 0, 0, 0); __builtin_amdgcn_s_setprio(0); } while (0)
#define PG8_WAIT_V(n) asm volatile("s_waitcnt vmcnt(" #n ")" ::: "memory")
#define PG8_WAIT_L(n) asm volatile("s_waitcnt lgkmcnt(" #n ")" ::: "memory")
#define PG8_BAR __builtin_amdgcn_s_barrier()
#define PG8_SCHED __builtin_amdgcn_sched_barrier(0)
    Unit cur, nxt; int ui = 0;
    if (!S.next(0, cur)) return;
    f32x4 acc[2][2][4][2];
#pragma unroll
    for (int a = 0; a < 2; ++a)
#pragma unroll
        for (int b = 0; b < 2; ++b)
#pragma unroll
            for (int m = 0; m < 4; ++m)
#pragma unroll
                for (int n = 0; n < 2; ++n) acc[a][b][m][n] = (f32x4){0.f, 0.f, 0.f, 0.f};
    bf16x8 At[4][2], B0[2][2], B1[2][2];
    const char* cA = (const char*)g.A + (size_t)cur.pm * tstep; const char* cB = (const char*)g.Bt + (size_t)cur.pn * tstep;
    S.a_ready(cur);
    if constexpr (SP2) {
        PG8_STAGE(PG8_SB(0, 0), cB, voffB); PG8_STAGE(PG8_SB(0, 1), cB + hstep, voffB); PG8_STAGE(PG8_SA(0, 0), cA, voffA); PG8_STAGE(PG8_SA(0, 1), cA + hstep, voffA);
        if (wr == 1) PG8_BAR;
        PG8_WAIT_V(2); PG8_BAR;
        PG8_STAGE(PG8_SB(1, 0), cB + kstep, voffB); PG8_STAGE(PG8_SA(1, 0), cA + kstep, voffA); PG8_STAGE(PG8_SB(1, 1), cB + hstep + kstep, voffB);
        PG8_WAIT_V(6); PG8_BAR;
    } else {
        PG8_STAGE(PG8_SB(0, 0), cB, voffB); PG8_STAGE(PG8_SA(0, 0), cA, voffA); PG8_STAGE(PG8_SB(0, 1), cB + hstep, voffB); PG8_STAGE(PG8_SA(0, 1), cA + hstep, voffA);
        if (wr == 1) PG8_BAR;
        PG8_WAIT_V(4); PG8_BAR;
        PG8_STAGE(PG8_SB(1, 0), cB + kstep, voffB); PG8_STAGE(PG8_SA(1, 0), cA + kstep, voffA); PG8_STAGE(PG8_SB(1, 1), cB + hstep + kstep, voffB);
        PG8_WAIT_V(6); PG8_BAR;
    }
    for (;;) {
        const bool has_next = S.next(ui + 1, nxt);
        const char* nA = has_next ? (const char*)g.A + (size_t)nxt.pm * tstep : cA; const char* nB = has_next ? (const char*)g.Bt + (size_t)nxt.pn * tstep : cB;
        for (int t = 0; t < nt; t += 2) {
            const bool last = (t == nt - 2);
            const char* a1 = cA + (size_t)(t + 1) * kstep;
            const char* a2 = last ? nA : cA + (size_t)(t + 2) * kstep; const char* b2 = last ? nB : cB + (size_t)(t + 2) * kstep;
            const char* a3 = a2 + kstep; const char* b3 = b2 + kstep;
            if (last && has_next) S.a_ready(nxt);
            if constexpr (SP2) {
            PG8_LDB(B0, 0, 0); PG8_LDB(B1, 0, 1); PG8_SCHED; PG8_LDA(At, 0, 0); PG8_STAGE(PG8_SA(1, 1), a1 + hstep, voffA);
            PG8_WAIT_V(8); PG8_WAIT_L(0); PG8_BAR; PG8_MMA(0, 0, At, B0); PG8_MMA(0, 1, At, B1); PG8_BAR; PG8_SCHED;
            PG8_LDA(At, 0, 1); PG8_STAGE(PG8_SB(0, 0), b2, voffB); PG8_STAGE(PG8_SB(0, 1), b2 + hstep, voffB); PG8_STAGE(PG8_SA(0, 0), a2, voffA);
            PG8_WAIT_V(8); PG8_WAIT_L(0); PG8_BAR; PG8_MMA(1, 0, At, B0); PG8_MMA(1, 1, At, B1); PG8_BAR; PG8_SCHED;
            PG8_LDB(B0, 1, 0); PG8_LDB(B1, 1, 1); PG8_SCHED; PG8_LDA(At, 1, 0); PG8_STAGE(PG8_SA(0, 1), a2 + hstep, voffA);
            PG8_WAIT_V(8); PG8_WAIT_L(0); PG8_BAR; PG8_MMA(0, 0, At, B0); PG8_MMA(0, 1, At, B1); PG8_BAR; PG8_SCHED;
            PG8_LDA(At, 1, 1); PG8_STAGE(PG8_SB(1, 0), b3, voffB); PG8_STAGE(PG8_SB(1, 1), b3 + hstep, voffB); PG8_STAGE(PG8_SA(1, 0), a3, voffA);
            PG8_WAIT_V(8); PG8_WAIT_L(0); PG8_BAR; PG8_MMA(1, 0, At, B0); PG8_MMA(1, 1, At, B1); PG8_BAR; PG8_SCHED;
            } else {
            PG8_LDB(B0, 0, 0); PG8_SCHED; PG8_LDA(At, 0, 0); PG8_STAGE(PG8_SA(1, 1), a1 + hstep, voffA);
            PG8_WAIT_L(8); PG8_BAR; PG8_WAIT_L(0); PG8_MMA(0, 0, At, B0); PG8_BAR; PG8_SCHED;
            PG8_LDB(B1, 0, 1); PG8_STAGE(PG8_SB(0, 0), b2, voffB);
            PG8_BAR; PG8_WAIT_L(0); PG8_MMA(0, 1, At, B1); PG8_BAR;
            PG8_LDA(At, 0, 1); PG8_STAGE(PG8_SA(0, 0), a2, voffA);
            PG8_BAR; PG8_WAIT_L(0); PG8_MMA(1, 0, At, B0); PG8_BAR; PG8_SCHED;
            PG8_STAGE(PG8_SB(0, 1), b2 + hstep, voffB);
            PG8_WAIT_V(6); PG8_BAR; PG8_MMA(1, 1, At, B1); PG8_BAR;
            PG8_LDB(B0, 1, 0); PG8_SCHED; PG8_LDA(At, 1, 0); PG8_STAGE(PG8_SA(0, 1), a2 + hstep, voffA);
            PG8_WAIT_L(8); PG8_BAR; PG8_WAIT_L(0); PG8_MMA(0, 0, At, B0); PG8_BAR; PG8_SCHED;
            PG8_LDB(B1, 1, 1); PG8_STAGE(PG8_SB(1, 0), b3, voffB);
            PG8_BAR; PG8_WAIT_L(0); PG8_MMA(0, 1, At, B1); PG8_BAR;
            PG8_LDA(At, 1, 1); PG8_STAGE(PG8_SA(1, 0), a3, voffA);
            PG8_BAR; PG8_WAIT_L(0); PG8_MMA(1, 0, At, B0); PG8_BAR; PG8_SCHED;
            PG8_STAGE(PG8_SB(1, 1), b3 + hstep, voffB);
            PG8_WAIT_V(6); PG8_BAR; PG8_MMA(1, 1, At, B1); PG8_BAR;
            }
        }
        if constexpr (ALIGN_EPI) { if (wr == 0) PG8_BAR; }
        if constexpr (!Epi::AFTER_DRAIN) { E(acc, cur, wr, wc, fr, fq); S.done(cur); }
        if (!has_next) break;
#pragma unroll
        for (int a = 0; a < 2; ++a)
#pragma unroll
            for (int b = 0; b < 2; ++b)
#pragma unroll
                for (int m = 0; m < 4; ++m)
#pragma unroll
                    for (int n = 0; n < 2; ++n) acc[a][b][m][n] = (f32x4){0.f, 0.f, 0.f, 0.f};
        cur = nxt; cA = nA; cB = nB; ++ui;
        if constexpr (ALIGN_EPI) { if (wr == 1) PG8_BAR; }
    }
    PG8_WAIT_V(0);
    if constexpr (!ALIGN_EPI) { if (wr == 0) PG8_BAR; }
    PG8_BAR;
    if constexpr (Epi::AFTER_DRAIN) { E.fused(acc, cur, wr, wc, fr, fq, lds, wid, lane); S.done(cur); }
#undef PG8_SA
#undef PG8_SB
#undef PG8_STAGE
#undef PG8_LDA
#undef PG8_LDB
#undef PG8_MMA
#undef PG8_WAIT_V
#undef PG8_WAIT_L
#undef PG8_BAR
#undef PG8_SCHED
}
}

#ifndef PG8_SP2
#define PG8_SP2 true
#endif
#ifndef PG8_ALIGN
#define PG8_ALIGN true
#endif
namespace attn_body {
using bf16=__hip_bfloat16;
using bf16x8=__attribute__((ext_vector_type(8)))short;
using s16x4=__attribute__((ext_vector_type(4)))short;
using f32x16=__attribute__((ext_vector_type(16)))float;
using u32x4=__attribute__((ext_vector_type(4)))unsigned;
constexpr int SEQ=16384,D=64,PQ=6144,PO=1024;
constexpr int NW=8,QBLK=32,QB=QBLK*NW,KVBLK=64,NQB=SEQ/QB;
constexpr int ATTN_UNIT_ROWS=QB;
__device__ __forceinline__ int crow(int r,int hi){return (r&3)+8*(r>>2)+4*hi;}
#define SBAR() __builtin_amdgcn_sched_barrier(0)
__device__ __forceinline__ void cmask(f32x16&p0,f32x16&p1,int jb,int qrel,int hi){
  const float NEG=-INFINITY; int kb=64*jb+4*hi;
  #pragma unroll
  for(int r=0;r<16;++r){int kv=kb+(r&3)+8*(r>>2); if(kv>qrel)p0[r]=NEG; if(kv+32>qrel)p1[r]=NEG;}
}

constexpr int NSLOT=3, SLOTB=8192;
constexpr int LDS_K=0, LDS_V=NSLOT*SLOTB, LDS_WS=3*NSLOT*SLOTB, LDS_OST=LDS_WS+NW*64*4, LDS_Q=LDS_OST+NW*4096, LDS_BYTES=LDS_Q+NW*4096;
constexpr float C2=0.125f*1.4426950408889634f;
__device__ __forceinline__ void glds16(const void*gsrc,unsigned lds_dst){unsigned keep;
  asm volatile("s_mov_b32 %0, m0\n\ts_mov_b32 m0, %2\n\ts_nop 0\n\tglobal_load_lds_dwordx4 %1, off\n\ts_mov_b32 m0, %0":"=&s"(keep):"v"(gsrc),"s"(lds_dst):"memory");}
__device__ __forceinline__ void glds16s(const void*sbase,unsigned voff,unsigned lds_dst){unsigned keep;
  asm volatile("s_mov_b32 %0, m0\n\ts_mov_b32 m0, %3\n\ts_nop 0\n\tglobal_load_lds_dwordx4 %1, %2\n\ts_mov_b32 m0, %0":"=&s"(keep):"v"(voff),"s"(sbase),"s"(lds_dst):"memory");}
__device__ __forceinline__ float max3f(float a,float b,float c){float r;asm("v_max3_f32 %0, %1, %2, %3":"=v"(r):"v"(a),"v"(b),"v"(c));return r;}
__device__ __forceinline__ float max2f(float a,float b){float r;asm("v_max_f32_e32 %0, %1, %2":"=v"(r):"v"(a),"v"(b));return r;}
__device__ __forceinline__ float fadd_s(float a,float b){float r;asm("v_add_f32_e32 %0, %1, %2":"=v"(r):"v"(a),"v"(b));return r;}
__device__ __forceinline__ float fsub_s(float a,float b){float r;asm("v_sub_f32_e32 %0, %1, %2":"=v"(r):"v"(a),"v"(b));return r;}
typedef float f32x2_t __attribute__((ext_vector_type(2))); typedef __bf16 bf16x2_t __attribute__((ext_vector_type(2)));
__device__ __forceinline__ unsigned cvtpk_s(float lo,float hi){f32x2_t v={lo,hi};bf16x2_t b=__builtin_convertvector(v,bf16x2_t);return __builtin_bit_cast(unsigned,b);}
#define WAIT_BAR(N) asm volatile("s_waitcnt vmcnt(" #N ") lgkmcnt(0)\n\ts_barrier":::"memory")

__device__ __forceinline__ void qkt(f32x16&p0,f32x16&p1,const char*Kslot,const bf16x8*qr,const f32x16&negm,int r32,int hi){
  const char*kb=Kslot+hi*1024+r32*16;
  #pragma unroll
  for(int d0=0;d0<4;++d0){
    const bf16x8 b0=*reinterpret_cast<const bf16x8*>(kb+d0*2048);
    const bf16x8 b1=*reinterpret_cast<const bf16x8*>(kb+d0*2048+512);
    if(d0==0){p0=__builtin_amdgcn_mfma_f32_32x32x16_bf16(b0,qr[0],negm,0,0,0);p1=__builtin_amdgcn_mfma_f32_32x32x16_bf16(b1,qr[0],negm,0,0,0);}
    else{p0=__builtin_amdgcn_mfma_f32_32x32x16_bf16(b0,qr[d0],p0,0,0,0);p1=__builtin_amdgcn_mfma_f32_32x32x16_bf16(b1,qr[d0],p1,0,0,0);}}
}
typedef __attribute__((address_space(3))) const char* lds_cptr;
typedef short v4i16_t __attribute__((ext_vector_type(4)));
__device__ __forceinline__ void kload8(bf16x8*kf,lds_cptr kp){
  kf[0]=*(const __attribute__((address_space(3))) bf16x8*)(kp);      kf[1]=*(const __attribute__((address_space(3))) bf16x8*)(kp+512);
  kf[2]=*(const __attribute__((address_space(3))) bf16x8*)(kp+2048); kf[3]=*(const __attribute__((address_space(3))) bf16x8*)(kp+2560);
  kf[4]=*(const __attribute__((address_space(3))) bf16x8*)(kp+4096); kf[5]=*(const __attribute__((address_space(3))) bf16x8*)(kp+4608);
  kf[6]=*(const __attribute__((address_space(3))) bf16x8*)(kp+6144); kf[7]=*(const __attribute__((address_space(3))) bf16x8*)(kp+6656);
}
__device__ __forceinline__ void kload2(bf16x8*kf,lds_cptr kp,int j){ kf[2*j]=*(const __attribute__((address_space(3))) bf16x8*)(kp+j*2048); kf[2*j+1]=*(const __attribute__((address_space(3))) bf16x8*)(kp+j*2048+512); }
__device__ __forceinline__ s16x4 vtr(lds_cptr p){ return __builtin_bit_cast(s16x4,__builtin_amdgcn_ds_read_tr16_b64_v4i16((__attribute__((address_space(3))) v4i16_t*)p)); }
__device__ __forceinline__ float rowmax(const f32x16&p0,const f32x16&p1){
  float a=max3f(p0[0],p0[1],p1[0]),b=max3f(p0[2],p0[3],p1[1]);a=max3f(a,p1[2],p1[3]);
  #pragma unroll
  for(int r=4;r<16;r+=4){a=max3f(a,p0[r],p0[r+1]);b=max3f(b,p0[r+2],p0[r+3]);a=max3f(a,p1[r],p1[r+1]);b=max3f(b,p1[r+2],p1[r+3]);}
  const float m=max2f(a,b);
  auto rr=__builtin_amdgcn_permlane32_swap(__float_as_uint(m),__float_as_uint(m),false,false);
  return max2f(__uint_as_float(rr[0]),__uint_as_float(rr[1]));
}
__device__ __forceinline__ void pv(f32x16*o,int vb,bf16x8 pa0,bf16x8 pa1,bf16x8 pa2,bf16x8 pa3){
  #pragma unroll
  for(int d0=0;d0<2;++d0){s16x4 lo[4],hi[4];
    #pragma unroll
    for(int ks=0;ks<4;++ks){
      asm volatile("ds_read_b64_tr_b16 %0,%1 offset:%c2":"=&v"(lo[ks]):"v"(vb),"i"(d0*4096+ks*1024):"memory");
      asm volatile("ds_read_b64_tr_b16 %0,%1 offset:%c2":"=&v"(hi[ks]):"v"(vb),"i"(d0*4096+ks*1024+512):"memory");}
    asm volatile("s_waitcnt lgkmcnt(0)":::"memory");SBAR();
    #define PK(k) (bf16x8){lo[k][0],lo[k][1],lo[k][2],lo[k][3],hi[k][0],hi[k][1],hi[k][2],hi[k][3]}
    o[d0]=__builtin_amdgcn_mfma_f32_32x32x16_bf16(pa0,PK(0),o[d0],0,0,0);
    o[d0]=__builtin_amdgcn_mfma_f32_32x32x16_bf16(pa1,PK(1),o[d0],0,0,0);
    o[d0]=__builtin_amdgcn_mfma_f32_32x32x16_bf16(pa2,PK(2),o[d0],0,0,0);
    o[d0]=__builtin_amdgcn_mfma_f32_32x32x16_bf16(pa3,PK(3),o[d0],0,0,0);
    #undef PK
  }
}

#ifndef ATTN_STORE16
#define ATTN_STORE16(p,v) (*(u32x4*)(p)=(v))
#endif
template<int THRL> __device__ __forceinline__ void attn_unit(const int tid,int b,int qb,const bf16*Q,const bf16*__restrict__ K,const bf16*__restrict__ V,bf16*O,char*shm){
  const int lane=tid&63,r32=lane&31,hi=lane>>5; const int wid=__builtin_amdgcn_readfirstlane(tid>>6);
  const long rowbase=(long)b*SEQ; const int q0=qb*QB;
  const bf16*Qw=Q+(rowbase+q0+wid*QBLK)*PQ;
  const bf16*Kh=K+rowbase*PQ,*Vh=V+rowbase*PQ;
  const unsigned lds0=(unsigned)(uintptr_t)shm;
  float*wsf=(float*)(shm+LDS_WS)+wid*64;
  const unsigned koff=(unsigned)((lane*PQ+wid*8)*2);
  const unsigned voff=(unsigned)(((16*(wid&3)+(lane>>2))*PQ+(wid>>2)*32+(lane&3)*8)*2);
  const unsigned kdst=lds0+LDS_K+wid*1024, vdst=lds0+LDS_V+wid*1024;
  #define DMA_K(t,slot) glds16s(Kh+(long)(t)*KVBLK*PQ,koff,(unsigned)__builtin_amdgcn_readfirstlane(kdst+(slot)))
  #define DMA_V(t,slot) do{ glds16s(Vh+(long)(t)*KVBLK*PQ,voff,(unsigned)__builtin_amdgcn_readfirstlane(vdst+2*(slot))); glds16s(Vh+64+(long)(t)*KVBLK*PQ,voff,(unsigned)__builtin_amdgcn_readfirstlane(vdst+2*(slot)+8192)); }while(0)
  const int vb0=(int)(lds0+LDS_V)+((lane>>4)&1)*32+(lane&3)*8+(4*hi+((lane&15)>>2))*64;
  const char*Kbase=shm+LDS_K; bf16x8 kf[8];
  const lds_cptr shm3=(lds_cptr)shm; const lds_cptr kp0=shm3+LDS_K+hi*1024+r32*16; const lds_cptr vp0=shm3+LDS_V+((lane>>4)&1)*32+(lane&3)*8+(4*hi+((lane&15)>>2))*64;
  const int NT=(q0+QB)/KVBLK;
  DMA_K(0,0);DMA_V(0,0);DMA_K(1,SLOTB);
  bf16x8 qr[4];
  #pragma unroll
  for(int d0=0;d0<4;++d0)qr[d0]=*reinterpret_cast<const bf16x8*>(&Qw[(long)r32*PQ+d0*16+hi*8]);
  float mhat=0.f,l_reg=0.f;f32x16 o[4];o[0]=f32x16{};o[1]=f32x16{};o[2]=f32x16{};o[3]=f32x16{};const f32x16 zero16=f32x16{};
  const int qrel=wid*QBLK+r32;
  #define CMASK(P0,P1,t) do{int jb_=(t)-(NT-4); if(jb_>=0)cmask(P0,P1,jb_,qrel,hi);}while(0)
  bool resc=false;
  #define START(P0,P1) do{ const float rm=rowmax(P0,P1); resc=false; \
    { const float dl=rm; mhat=fadd_s(mhat,dl); \
      _Pragma("unroll") for(int r=0;r<16;++r){P0[r]=fsub_s(P0[r],dl);P1[r]=fsub_s(P1[r],dl);} \
      } \
    _Pragma("unroll") for(int r=0;r<16;++r)P0[r]=__builtin_amdgcn_exp2f(P0[r]); }while(0)
  #define RESC() do{ if(resc){ asm volatile("s_waitcnt lgkmcnt(0)":::"memory"); \
      _Pragma("unroll") for(int d_=0;d_<4;++d_) _Pragma("unroll") for(int r=0;r<16;++r)o[d_][r]*=wsf[crow(r,hi)]; } }while(0)
  f32x16 pA0,pA1,pB0,pB1;
  int sl_prev=0,sl_cur=0,sl_next=SLOTB;
  #define ROT() do{sl_prev=sl_cur;sl_cur=sl_next;sl_next=(sl_next==(NSLOT-1)*SLOTB)?0:sl_next+SLOTB;}while(0)
  DMA_K(2,2*SLOTB);
  WAIT_BAR(4);
  qkt(pA0,pA1,Kbase,qr,zero16,r32,hi);asm volatile("s_nop 15\n\ts_nop 7":"+v"(pA0),"+v"(pA1));CMASK(pA0,pA1,0);
  START(pA0,pA1);
  _Pragma("unroll") for(int r=0;r<16;++r)pA1[r]=__builtin_amdgcn_exp2f(pA1[r]);
  WAIT_BAR(0);
  DMA_K(3,0);DMA_V(1,SLOTB);
  ROT();
  kload8(kf,kp0+sl_cur);
  WAIT_BAR(3);
  s16x4 vlo[8],vhi[8]; u32x4 pw0,pw1,pw2,pw3;
  #define PKW(P,B) cvtpk_s(P[B],P[B+1])
  #define PAF(k) __builtin_bit_cast(bf16x8,pw##k)
  #define VFR(i) (bf16x8){vlo[i][0],vlo[i][1],vlo[i][2],vlo[i][3],vhi[i][0],vhi[i][1],vhi[i][2],vhi[i][3]}
  #define PIN(x) asm volatile("":"+v"(x))
  #define MX3(a,b,c) __builtin_fmaxf(__builtin_fmaxf((a),(b)),(c))
  #define GAPA(MF,A0,A1,A2,A3,W0,W1,PW) do{ MF; sacc+=A0; sacc+=A1; sacc+=A2; sacc+=A3; PIN(sacc); W0; W1; PIN(PW); SBAR(); }while(0)
  #define EX(v) __builtin_amdgcn_exp2f(v)
  #define GAPB(MF,X,B) do{ MF; X[B]=EX(X[B]); X[B+1]=EX(X[B+1]); X[B+2]=EX(X[B+2]); X[B+3]=EX(X[B+3]); PIN(X); SBAR(); }while(0)
  #define GAPB2(MF,X,B) do{ MF; X[B]=EX(X[B]); X[B+1]=EX(X[B+1]); PIN(X); SBAR(); }while(0)
  #define VRD(i) do{ vlo[i]=vtr(vp_+(((i)>>2)*4096+((i)&3)*1024)); vhi[i]=vtr(vp_+(((i)>>2)*4096+((i)&3)*1024+512)); }while(0)
  #define VRD2(i) do{ vlo[i]=vtr(vp_+8192+(((i)>>2)*4096+((i)&3)*1024)); vhi[i]=vtr(vp_+8192+(((i)>>2)*4096+((i)&3)*1024+512)); }while(0)
  #define KRD(G,j) do{ if(G){ kload2(kf,kp0+sl_next,j); SBAR(); } }while(0)
  #define STEP(C0,C1,P0,P1,t,GK,GV,GL) do{ SBAR(); \
    const lds_cptr vp_=vp0+2*sl_prev; \
    VRD(0); SBAR(); float sacc=(P0[0]+P0[1]); \
    GAPA(C0=__builtin_amdgcn_mfma_f32_32x32x16_bf16(kf[0],qr[0],zero16,0,0,0), P0[2],P0[3],P0[4],P0[5],     pw0[0]=PKW(P0,0), pw0[1]=PKW(P0,2), pw0); \
    VRD(4); SBAR(); GAPA(C1=__builtin_amdgcn_mfma_f32_32x32x16_bf16(kf[1],qr[0],zero16,0,0,0), P0[6],P0[7],P0[8],P0[9],     pw0[2]=PKW(P0,4), pw0[3]=PKW(P0,6), pw0); \
    VRD(1); SBAR(); GAPA(C0=__builtin_amdgcn_mfma_f32_32x32x16_bf16(kf[2],qr[1],C0,0,0,0),   P0[10],P0[11],P0[12],P0[13], pw1[0]=PKW(P0,8), pw1[1]=PKW(P0,10), pw1); \
    VRD(5); SBAR(); GAPA(C1=__builtin_amdgcn_mfma_f32_32x32x16_bf16(kf[3],qr[1],C1,0,0,0),   P0[14],P0[15],P1[0],P1[1],   pw1[2]=PKW(P0,12),pw1[3]=PKW(P0,14), pw1); \
    VRD(2); SBAR(); GAPA(C0=__builtin_amdgcn_mfma_f32_32x32x16_bf16(kf[4],qr[2],C0,0,0,0),   P1[2],P1[3],P1[4],P1[5],     pw2[0]=PKW(P1,0), pw2[1]=PKW(P1,2), pw2); \
    VRD(6); SBAR(); GAPA(C1=__builtin_amdgcn_mfma_f32_32x32x16_bf16(kf[5],qr[2],C1,0,0,0),   P1[6],P1[7],P1[8],P1[9],     pw2[2]=PKW(P1,4), pw2[3]=PKW(P1,6), pw2); \
    VRD(3); SBAR(); GAPA(C0=__builtin_amdgcn_mfma_f32_32x32x16_bf16(kf[6],qr[3],C0,0,0,0),   P1[10],P1[11],P1[12],P1[13], pw3[0]=PKW(P1,8), pw3[1]=PKW(P1,10), pw3); \
    VRD(7); SBAR(); GAPA(C1=__builtin_amdgcn_mfma_f32_32x32x16_bf16(kf[7],qr[3],C1,0,0,0),   P1[14],P1[15],0.f,0.f,       pw3[2]=PKW(P1,12),pw3[3]=PKW(P1,14), pw3); \
    l_reg+=sacc; \
    if(GK){DMA_K((t)+3,sl_cur);} if(GV){DMA_V((t)+1,sl_next);} \
    _Pragma("unroll") for(int r=0;r<16;++r){C0[r]-=mhat;C1[r]-=mhat;} \
    CMASK(C0,C1,t); \
    { float a=MX3(C0[0],C0[1],C1[0]),b=MX3(C0[2],C0[3],C1[1]); a=MX3(a,C1[2],C1[3]); \
      _Pragma("unroll") for(int r=4;r<16;r+=4){a=MX3(a,C0[r],C0[r+1]);b=MX3(b,C0[r+2],C0[r+3]);a=MX3(a,C1[r],C1[r+1]);b=MX3(b,C1[r+2],C1[r+3]);} \
      float rm=__builtin_fmaxf(a,b); { auto rr=__builtin_amdgcn_permlane32_swap(__float_as_uint(rm),__float_as_uint(rm),false,false); rm=__builtin_fmaxf(__uint_as_float(rr[0]),__uint_as_float(rr[1])); } \
      resc=false; \
      if(__builtin_expect(__any(rm>(float)THRL),0)){ const float dl=__builtin_fmaxf(rm,0.f); mhat+=dl; \
        _Pragma("unroll") for(int r=0;r<16;++r){C0[r]-=dl;C1[r]-=dl;} \
        const float f=__builtin_amdgcn_exp2f(-dl); l_reg*=f; if(hi==0)wsf[r32]=f; resc=true; } } \
    SBAR(); \
      \
      \
    GAPB2(o[0]=__builtin_amdgcn_mfma_f32_32x32x16_bf16(PAF(0),VFR(0),o[0],0,0,0), C0,0); \
    GAPB2(o[1]=__builtin_amdgcn_mfma_f32_32x32x16_bf16(PAF(0),VFR(4),o[1],0,0,0), C0,2); \
    KRD(GL,0); GAPB2(o[0]=__builtin_amdgcn_mfma_f32_32x32x16_bf16(PAF(1),VFR(1),o[0],0,0,0), C0,4); VRD2(0); SBAR(); \
    KRD(GL,1); GAPB2(o[1]=__builtin_amdgcn_mfma_f32_32x32x16_bf16(PAF(1),VFR(5),o[1],0,0,0), C0,6); VRD2(4); SBAR(); \
    KRD(GL,2); GAPB2(o[0]=__builtin_amdgcn_mfma_f32_32x32x16_bf16(PAF(2),VFR(2),o[0],0,0,0), C0,8); VRD2(1); SBAR(); \
    KRD(GL,3); GAPB2(o[1]=__builtin_amdgcn_mfma_f32_32x32x16_bf16(PAF(2),VFR(6),o[1],0,0,0), C0,10); VRD2(5); SBAR(); \
    GAPB2(o[0]=__builtin_amdgcn_mfma_f32_32x32x16_bf16(PAF(3),VFR(3),o[0],0,0,0), C0,12); VRD2(2); SBAR(); \
    GAPB2(o[1]=__builtin_amdgcn_mfma_f32_32x32x16_bf16(PAF(3),VFR(7),o[1],0,0,0), C0,14); VRD2(6); SBAR(); \
    GAPB2(o[2]=__builtin_amdgcn_mfma_f32_32x32x16_bf16(PAF(0),VFR(0),o[2],0,0,0), C1,0); VRD2(3); SBAR(); \
    GAPB2(o[3]=__builtin_amdgcn_mfma_f32_32x32x16_bf16(PAF(0),VFR(4),o[3],0,0,0), C1,2); VRD2(7); SBAR(); \
    GAPB2(o[2]=__builtin_amdgcn_mfma_f32_32x32x16_bf16(PAF(1),VFR(1),o[2],0,0,0), C1,4); \
    GAPB2(o[3]=__builtin_amdgcn_mfma_f32_32x32x16_bf16(PAF(1),VFR(5),o[3],0,0,0), C1,6); \
    GAPB2(o[2]=__builtin_amdgcn_mfma_f32_32x32x16_bf16(PAF(2),VFR(2),o[2],0,0,0), C1,8); \
    GAPB2(o[3]=__builtin_amdgcn_mfma_f32_32x32x16_bf16(PAF(2),VFR(6),o[3],0,0,0), C1,10); \
    GAPB2(o[2]=__builtin_amdgcn_mfma_f32_32x32x16_bf16(PAF(3),VFR(3),o[2],0,0,0), C1,12); \
    GAPB2(o[3]=__builtin_amdgcn_mfma_f32_32x32x16_bf16(PAF(3),VFR(7),o[3],0,0,0), C1,14); \
    }while(0)
  int t=1;
  #undef CMASK
  #define CMASK(P0,P1,t) do{}while(0)
  for(;t+5<NT;t+=2){
    STEP(pB0,pB1,pA0,pA1,t,true,true,true);     WAIT_BAR(3); RESC(); ROT();
    STEP(pA0,pA1,pB0,pB1,t+1,true,true,true);   WAIT_BAR(3); RESC(); ROT();
  }
  #undef CMASK
  #define CMASK(P0,P1,t) do{int jb_=(t)-(NT-4); if(jb_>=0)cmask(P0,P1,jb_,qrel,hi);}while(0)
  #define ENDW(tt) do{ if((tt)+3<NT){WAIT_BAR(3);} else if((tt)+2<NT){WAIT_BAR(2);} else {WAIT_BAR(0);} }while(0)
  for(;t+1<NT;t+=2){
    STEP(pB0,pB1,pA0,pA1,t,(t+3<NT),(t+1<NT),(t+1<NT));       ENDW(t);   RESC(); ROT();
    STEP(pA0,pA1,pB0,pB1,t+1,(t+4<NT),(t+2<NT),(t+2<NT));     ENDW(t+1); RESC(); ROT();
  }
  STEP(pB0,pB1,pA0,pA1,NT-1,false,false,false); RESC();
  { float sacc=pB0[0]+pB0[1]; _Pragma("unroll") for(int r=2;r<16;++r)sacc+=pB0[r]; _Pragma("unroll") for(int r=0;r<16;++r)sacc+=pB1[r]; l_reg+=sacc;
    pw0=(u32x4){PKW(pB0,0),PKW(pB0,2),PKW(pB0,4),PKW(pB0,6)};pw1=(u32x4){PKW(pB0,8),PKW(pB0,10),PKW(pB0,12),PKW(pB0,14)};pw2=(u32x4){PKW(pB1,0),PKW(pB1,2),PKW(pB1,4),PKW(pB1,6)};pw3=(u32x4){PKW(pB1,8),PKW(pB1,10),PKW(pB1,12),PKW(pB1,14)};
    SBAR(); pv(o,vb0+2*sl_cur,PAF(0),PAF(1),PAF(2),PAF(3)); pv(o+2,vb0+2*sl_cur+8192,PAF(0),PAF(1),PAF(2),PAF(3)); }
  #undef PKW
  #undef PAF
  #undef VFR
  #undef PIN
  #undef MX3
  #undef GAPA
  #undef GAPB
  #undef GAPB2
  #undef EX
  #undef VRD
  #undef VRD2
  #undef KRD
  #undef STEP
  #undef ENDW
  {auto rr=__builtin_amdgcn_permlane32_swap(__float_as_uint(l_reg),__float_as_uint(l_reg),false,false);l_reg=__uint_as_float(rr[0])+__uint_as_float(rr[1]);}
  if(hi==0)wsf[32+r32]=l_reg;asm volatile("s_waitcnt lgkmcnt(0)":::"memory");
  float rli[16];
  #pragma unroll
  for(int r=0;r<16;++r)rli[r]=__builtin_amdgcn_rcpf(wsf[32+crow(r,hi)]);
  bf16*Ow=O+(rowbase+q0+wid*QBLK)*PO;
  { bf16*stg=(bf16*)(shm+LDS_OST)+wid*2048;
    #pragma unroll
    for(int hf=0;hf<2;++hf){
      #pragma unroll
      for(int r=0;r<16;++r){const int orow=crow(r,hi);
        #pragma unroll
        for(int d0=0;d0<2;++d0)stg[orow*64+d0*32+r32]=__float2bfloat16(o[2*hf+d0][r]*rli[r]);}
      asm volatile("s_waitcnt lgkmcnt(0)":::"memory");
      #pragma unroll
      for(int i=0;i<4;++i){const int row=i*8+(lane>>3),ch=lane&7; const u32x4 v=*(const u32x4*)(stg+row*64+ch*8); ATTN_STORE16(Ow+(long)row*PO+hf*64+ch*8,v);}
      asm volatile("s_waitcnt lgkmcnt(0)":::"memory"); } }
  asm volatile("s_waitcnt lgkmcnt(0)\n\ts_barrier":::"memory");
  #undef DMA_K
  #undef DMA_V
  #undef CMASK
  #undef START
  #undef RESC
  #undef ROT
}
constexpr int ATTN_LDS_BYTES=LDS_BYTES;
#undef SBAR
#undef WAIT_BAR
}
constexpr int NWAVES = 8;
constexpr int BATCH = 2, SEQ = 16384, DM = 2048, M = BATCH * SEQ, NMEM = 256;
constexpr int IN_W = 6160, PJ = 6144;
constexpr int C_GQ = 0, C_GK = 512, C_GV = 1024, C_GG = 2048, C_DQ = 3072, C_DK = 3584, C_DV = 4096, C_DG = 4608, C_MQ = 5120, C_MG = 5632;
constexpr float LN_EPS = 1e-5f, GLA_EPS = 1e-6f, DIFF_EPS = 1e-5f;
constexpr float ALPHA = 1.189207115002721f;
constexpr float LAM_INIT = 0.2f;
constexpr size_t MiB = 1u << 20;
constexpr size_t WS_CTL = 0, CTL_ZERO_BYTES = 32768;
constexpr size_t WS_WIN_T = 2 * MiB, WS_WOUT_T = 26 * MiB, WS_WMKV_T = 34 * MiB, WS_MEMB = 38 * MiB, WS_MK = 40 * MiB, WS_MVT = 41 * MiB;
constexpr size_t WS_CS = 42 * MiB, WS_GLR = 44 * MiB, WS_XB = 48 * MiB, WS_PROJ = 176 * MiB, WS_OBUF = 560 * MiB, WS_QF = 624 * MiB, WS_KF = 656 * MiB, WS_VF = 688 * MiB, WS_AL = 752 * MiB, WS_OI = 754 * MiB, WS_OX = 818 * MiB, WS_END = 882 * MiB;
constexpr size_t WS_MIX = WS_XB;
constexpr size_t WS_OUTB = WS_PROJ;
constexpr int RING_BYTES = 131072, CHAIN_RING_BYTES = 3 * 49 * 1024, MISC_OFF = CHAIN_RING_BYTES + 1024, WSF_OFF = CHAIN_RING_BYTES + 2048, LDS_BYTES = CHAIN_RING_BYTES + 5120;

#define GAS __attribute__((address_space(1)))
#define LAS __attribute__((address_space(3)))
#define DI __device__ __forceinline__
typedef unsigned short bf16;
typedef unsigned v4u __attribute__((ext_vector_type(4)));
typedef unsigned v2u __attribute__((ext_vector_type(2)));
typedef float f32x4 __attribute__((ext_vector_type(4)));
typedef float f32x16 __attribute__((ext_vector_type(16)));
typedef short bf16x8 __attribute__((ext_vector_type(8)));
typedef short s16x4 __attribute__((ext_vector_type(4)));
typedef float f32x2_t __attribute__((ext_vector_type(2))); typedef __bf16 bf16x2_t __attribute__((ext_vector_type(2)));
DI unsigned cvtpk(float lo, float hi) { f32x2_t v = {lo, hi}; bf16x2_t b = __builtin_convertvector(v, bf16x2_t); return __builtin_bit_cast(unsigned, b); }
DI float bf2f(unsigned short u) { return __uint_as_float((unsigned)u << 16); }
DI float bflo(unsigned u) { return __uint_as_float(u << 16); }
DI float bfhi(unsigned u) { return __uint_as_float(u & 0xffff0000u); }
DI int crow(int r, int hi) { return (r & 3) + 8 * (r >> 2) + 4 * hi; }
DI float wave_sum(float v) {
#pragma unroll
    for (int o = 1; o < 64; o <<= 1) v += __shfl_xor(v, o);
    return v;
}
DI int fresh_tid(int wv) { int t = wv * 64 + (int)__builtin_amdgcn_mbcnt_hi(~0u, __builtin_amdgcn_mbcnt_lo(~0u, 0u)); asm volatile("" : "+v"(t)); return t; }
DI float silu(float g) { return g * __builtin_amdgcn_rcpf(1.f + __expf(-g)); }
#define MFMA32(a, b, c) __builtin_amdgcn_mfma_f32_32x32x16_bf16((a), (b), (c), 0, 0, 0)
DI bf16x8 pack_step(const f32x16& x, int s) {
    v4u p;
    p.x = cvtpk(x[8 * s + 0], x[8 * s + 1]); p.y = cvtpk(x[8 * s + 2], x[8 * s + 3]); p.z = cvtpk(x[8 * s + 4], x[8 * s + 5]); p.w = cvtpk(x[8 * s + 6], x[8 * s + 7]);
    return __builtin_bit_cast(bf16x8, p);
}

struct Args {
    const float* x; const float* mem; const int* pos; const float* w_in; const float* w_gk_up; const float* b_gk_up; const float* gla_g;
    const float* lq1; const float* lk1; const float* lq2; const float* lk2; const float* diff_g; const float* w_mkv; const float* w_out; const float* ln_g; const float* ln_b;
    float* out; unsigned char* ws;
    float inv_freq[8];
    int ph_lo, ph_hi, coop, pad;
};

DI void p0_transpose_item(const float* W, int ldw, int K, int ncols, bf16* WT, int row_off, LAS float* scr, int item, int lane) {
    const int nblk = ncols / 32, kb = item / nblk, nb = item % nblk, k0 = 64 * kb, n0 = 32 * nb;
#pragma unroll 8
    for (int i = 0; i < 32; ++i) { const int kk = 2 * i + (lane >> 5); scr[kk * 33 + (lane & 31)] = W[(size_t)(k0 + kk) * ldw + n0 + (lane & 31)]; }
    asm volatile("s_waitcnt lgkmcnt(0)" ::: "memory");
    const int c = lane & 7;
#pragma unroll
    for (int j = 0; j < 4; ++j) { const int n = (lane >> 3) + 8 * j; const LAS float* s = scr + (8 * c) * 33 + n;
        v4u o; o.x = cvtpk(s[0 * 33], s[1 * 33]); o.y = cvtpk(s[2 * 33], s[3 * 33]); o.z = cvtpk(s[4 * 33], s[5 * 33]); o.w = cvtpk(s[6 * 33], s[7 * 33]);
        *(v4u*)(WT + (size_t)(row_off + n0 + n) * K + k0 + 8 * c) = o; }
    asm volatile("s_waitcnt lgkmcnt(0)" ::: "memory");
}
DI void p0_prologue(const Args& a, LAS unsigned char* lds, int bx, int G, int wv) {
    const int tid = fresh_tid(wv), lane = tid & 63, wave = __builtin_amdgcn_readfirstlane(tid >> 6);
    unsigned char* ws = a.ws;
    LAS float* scr = (LAS float*)(lds + wave * 16384);
    const int gw = bx * NWAVES + wave, NGW = G * NWAVES;
    constexpr int I_IN = (DM / 64) * (3072 / 32), I_OUT = (DM / 64) * (DM / 32), I_MKV = (DM / 64) * (1024 / 32);
    constexpr int NITEMS = 2 * I_IN + I_OUT + I_MKV;
    for (int it = gw; it < NITEMS; it += NGW) {
        int r = it;
        if (r < I_IN) { p0_transpose_item(a.w_in, IN_W, DM, 3072, (bf16*)(ws + WS_WIN_T), 0, scr, r, lane); continue; } r -= I_IN;
        if (r < I_IN) { p0_transpose_item(a.w_in + 3088, IN_W, DM, 3072, (bf16*)(ws + WS_WIN_T), 3072, scr, r, lane); continue; } r -= I_IN;
        if (r < I_OUT) { p0_transpose_item(a.w_out, DM, DM, DM, (bf16*)(ws + WS_WOUT_T), 0, scr, r, lane); continue; } r -= I_OUT;
        p0_transpose_item(a.w_mkv, 1024, DM, 1024, (bf16*)(ws + WS_WMKV_T), 0, scr, r, lane);
    }
    __syncthreads();
    LAS float* wT = (LAS float*)lds;
#pragma unroll 1
    for (int i0 = 0; i0 < 64; i0 += 16) {
        float t16[16];
#pragma unroll
        for (int i = 0; i < 16; ++i) { const int idx = tid + 512 * (i0 + i); t16[i] = a.w_in[(size_t)(idx >> 4) * IN_W + 3072 + (idx & 15)]; }
#pragma unroll
        for (int i = 0; i < 16; ++i) { const int idx = tid + 512 * (i0 + i); wT[(idx & 15) * 2048 + (idx >> 4)] = t16[i]; }
    }
    __syncthreads();
    float* glr = (float*)(ws + WS_GLR); bf16* xb = (bf16*)(ws + WS_XB);
    {
        f32x4 vn[8];
        if (gw < M) { const f32x4* xr = (const f32x4*)(a.x + (size_t)gw * DM) + lane;
#pragma unroll
            for (int j = 0; j < 8; ++j) vn[j] = __builtin_nontemporal_load(xr + 64 * j); }
        for (int row = gw; row < M; row += NGW) {
            f32x4 v[8];
#pragma unroll
            for (int j = 0; j < 8; ++j) v[j] = vn[j];
            if (row + NGW < M) { const f32x4* xr = (const f32x4*)(a.x + (size_t)(row + NGW) * DM) + lane;
#pragma unroll
                for (int j = 0; j < 8; ++j) vn[j] = __builtin_nontemporal_load(xr + 64 * j); }
            v2u* o8 = (v2u*)(xb + (size_t)row * DM) + lane;
#pragma unroll
            for (int j = 0; j < 8; ++j) { v2u o; o.x = cvtpk(v[j].x, v[j].y); o.y = cvtpk(v[j].z, v[j].w); o8[64 * j] = o; }
            float res = 0.f;
#pragma unroll 1
            for (int rg = 0; rg < 4; ++rg) {
                float ac0 = 0.f, ac1 = 0.f, ac2 = 0.f, ac3 = 0.f;
                const LAS float* wp = wT + rg * 4 * 2048 + 4 * lane;
#pragma unroll
                for (int j = 0; j < 8; ++j) {
                    const f32x4 w0 = *(const LAS f32x4*)(wp + 256 * j), w1 = *(const LAS f32x4*)(wp + 2048 + 256 * j), w2 = *(const LAS f32x4*)(wp + 4096 + 256 * j), w3 = *(const LAS f32x4*)(wp + 6144 + 256 * j);
                    ac0 += v[j].x * w0.x + v[j].y * w0.y + v[j].z * w0.z + v[j].w * w0.w;
                    ac1 += v[j].x * w1.x + v[j].y * w1.y + v[j].z * w1.z + v[j].w * w1.w;
                    ac2 += v[j].x * w2.x + v[j].y * w2.y + v[j].z * w2.z + v[j].w * w2.w;
                    ac3 += v[j].x * w3.x + v[j].y * w3.y + v[j].z * w3.z + v[j].w * w3.w;
                }
                const bool b0 = (lane & 1) != 0, b1 = (lane & 2) != 0;
                float a01 = (b0 ? ac1 : ac0) + __shfl_xor(b0 ? ac0 : ac1, 1);
                float a23 = (b0 ? ac3 : ac2) + __shfl_xor(b0 ? ac2 : ac3, 1);
                float bq = (b1 ? a23 : a01) + __shfl_xor(b1 ? a01 : a23, 2);
                bq += __shfl_xor(bq, 4); bq += __shfl_xor(bq, 8); bq += __shfl_xor(bq, 16); bq += __shfl_xor(bq, 32);
                res = ((lane >> 2) == rg) ? bq : res;
            }
            if (lane < 16) glr[(size_t)row * 16 + lane] = res;
        }
    }
    const int gt = bx * 512 + tid, NT = G * 512;
    float* cs = (float*)(ws + WS_CS);
    for (int idx = gt; idx < M * 8; idx += NT) {
        const int tok = idx >> 3, i = idx & 7;
        float invf = a.inv_freq[0];
#pragma unroll
        for (int q = 1; q < 8; ++q) invf = (i == q) ? a.inv_freq[q] : invf;
        const float ang = (float)a.pos[tok] * invf;
        double td = (double)ang * 0.15915494309189535; td -= rint(td);
        const float tf = (float)td;
        cs[(size_t)tok * 16 + i] = __builtin_amdgcn_cosf(tf); cs[(size_t)tok * 16 + 8 + i] = __builtin_amdgcn_sinf(tf);
    }
    bf16* memb = (bf16*)(ws + WS_MEMB);
    for (int idx = gt; idx < BATCH * NMEM * DM / 4; idx += NT) { const f32x4 v = ((const f32x4*)a.mem)[idx]; v2u o; o.x = cvtpk(v.x, v.y); o.y = cvtpk(v.z, v.w); ((v2u*)memb)[idx] = o; }
    __syncthreads();
}

constexpr int G_QS = 0, G_KS = 17408, G_KDT = 34816, G_VT = 53248, G_PS = 90112, G_GL = 99328, G_TOT = 103424, G_AL = 105472;
constexpr int QP = 272, KP = 144;
DI float log_sigmoid(float x) { return fminf(x, 0.f) - __logf(1.f + __expf(-fabsf(x))); }
DI void gla_pre(int u, const bf16* proj, const float* glr, const float* w_up, const float* b_up, bf16* QF, bf16* KF, bf16* VF, float* ALg, bf16* OI, LAS unsigned char* lds, int wv) {
    const int tid = fresh_tid(wv), lane = tid & 63, r32 = lane & 31, hi = lane >> 5, w = __builtin_amdgcn_readfirstlane(tid >> 6);
    const int b = u >> 10, h = (u >> 8) & 3, c = u & 255;
    const int dk = tid & 127, qt = tid >> 7;
    const int dvl = tid & 255, th = tid >> 8;
    LAS float* GL = (LAS float*)(lds + G_GL); LAS float* TOT = (LAS float*)(lds + G_TOT); LAS float* AL = (LAS float*)(lds + G_AL);
    const size_t tok0 = (size_t)b * SEQ + (size_t)c * 64;
    if (tid < 256) ((LAS f32x4*)GL)[tid] = ((const f32x4*)(glr + tok0 * 16))[tid];
    float wu[16];
#pragma unroll
    for (int r = 0; r < 16; ++r) wu[r] = w_up[r * 512 + h * 128 + dk];
    const float bu = b_up[h * 128 + dk];
    unsigned short qv[16], kv[16];
#pragma unroll
    for (int i = 0; i < 16; ++i) { const bf16* p = proj + (tok0 + 16 * qt + i) * PJ + h * 128 + dk; qv[i] = p[C_GQ]; kv[i] = p[C_GK]; }
    unsigned short vv[32];
#pragma unroll
    for (int i = 0; i < 32; ++i) vv[i] = proj[(tok0 + 32 * th + i) * PJ + C_GV + h * 256 + dvl];
    __syncthreads();
    float cb[16]; float run = 0.f;
#pragma unroll
    for (int i = 0; i < 16; ++i) {
        const LAS float* g = GL + (16 * qt + i) * 16; float lg = bu;
#pragma unroll
        for (int r = 0; r < 16; ++r) lg += g[r] * wu[r];
        run += log_sigmoid(lg) * (1.f / 16.f); cb[i] = run;
    }
    TOT[qt * 128 + dk] = run;
    {
        LAS unsigned char* vp = lds + G_VT + dvl * KP + th * 64;
#pragma unroll
        for (int q = 0; q < 4; ++q) { v4u o; o.x = vv[8 * q] | ((unsigned)vv[8 * q + 1] << 16); o.y = vv[8 * q + 2] | ((unsigned)vv[8 * q + 3] << 16);
            o.z = vv[8 * q + 4] | ((unsigned)vv[8 * q + 5] << 16); o.w = vv[8 * q + 6] | ((unsigned)vv[8 * q + 7] << 16); *(LAS v4u*)(vp + q * 16) = o; }
    }
    __syncthreads();
    float off = 0.f, total = 0.f;
#pragma unroll
    for (int q = 0; q < 4; ++q) { const float t = TOT[q * 128 + dk]; total += t; off += (q < qt) ? t : 0.f; }
    {
        const float etot = __expf(total);
        unsigned kdp[8];
#pragma unroll
        for (int i = 0; i < 16; i += 2) {
            const float e0 = __expf(cb[i] + off), e1 = __expf(cb[i + 1] + off);
            const float r0 = __builtin_amdgcn_rcpf(e0), r1 = __builtin_amdgcn_rcpf(e1);
            const float k0 = bf2f(kv[i]) * r0, k1 = bf2f(kv[i + 1]) * r1;
            const unsigned qq = cvtpk(bf2f(qv[i]) * e0, bf2f(qv[i + 1]) * e1), kk = cvtpk(k0, k1);
            kdp[i >> 1] = cvtpk(k0 * etot, k1 * etot);
            const int t0 = 16 * qt + i;
            *(LAS unsigned short*)(lds + G_QS + t0 * QP + dk * 2) = (unsigned short)(qq & 0xffffu);
            *(LAS unsigned short*)(lds + G_QS + (t0 + 1) * QP + dk * 2) = (unsigned short)(qq >> 16);
            *(LAS unsigned short*)(lds + G_KS + t0 * QP + dk * 2) = (unsigned short)(kk & 0xffffu);
            *(LAS unsigned short*)(lds + G_KS + (t0 + 1) * QP + dk * 2) = (unsigned short)(kk >> 16);
        }
        LAS unsigned char* kp = lds + G_KDT + dk * KP + qt * 32;
        *(LAS v4u*)(kp) = (v4u){kdp[0], kdp[1], kdp[2], kdp[3]}; *(LAS v4u*)(kp + 16) = (v4u){kdp[4], kdp[5], kdp[6], kdp[7]};
        if (qt == 0) ALg[(size_t)u * 256 + dk] = etot;
    }
    __syncthreads();
    if (w < 3) {
        const int it = (w == 0) ? 0 : 1, jt = (w == 2) ? 1 : 0;
        f32x16 sT;
#pragma unroll
        for (int r = 0; r < 16; ++r) sT[r] = 0.f;
#pragma unroll
        for (int s = 0; s < 8; ++s) {
            const bf16x8 A = *(const LAS bf16x8*)(lds + G_KS + (32 * jt + r32) * QP + (16 * s + 8 * hi) * 2);
            const bf16x8 B = *(const LAS bf16x8*)(lds + G_QS + (32 * it + r32) * QP + (16 * s + 8 * hi) * 2);
            sT = MFMA32(A, B, sT);
        }
        const int ii = 32 * it + r32;
#pragma unroll
        for (int g = 0; g < 4; ++g) {
            const int j0 = 32 * jt + 8 * g + 4 * hi;
            const float p0 = (j0 + 0 <= ii) ? sT[4 * g + 0] : 0.f, p1 = (j0 + 1 <= ii) ? sT[4 * g + 1] : 0.f, p2 = (j0 + 2 <= ii) ? sT[4 * g + 2] : 0.f, p3 = (j0 + 3 <= ii) ? sT[4 * g + 3] : 0.f;
            *(LAS v2u*)(lds + G_PS + ii * KP + j0 * 2) = (v2u){cvtpk(p0, p1), cvtpk(p2, p3)};
        }
    } else if (w == 3) {
#pragma unroll
        for (int g = 0; g < 4; ++g) *(LAS v2u*)(lds + G_PS + r32 * KP + (32 + 8 * g + 4 * hi) * 2) = (v2u){0u, 0u};
    }
#pragma unroll
    for (int e = 0; e < 2; ++e) {
        const int f = 2 * w + e;
        { const int it = f >> 3, t = (f >> 1) & 3, s = f & 1;
          const LAS unsigned char* qp = lds + G_QS + (32 * it + r32) * QP + (32 * t + 16 * s + 4 * hi) * 2;
          const v2u lo = *(const LAS v2u*)(qp), hh = *(const LAS v2u*)(qp + 16);
          *(v4u*)(QF + (((size_t)u * 16 + f) * 64 + lane) * 8) = (v4u){lo.x, lo.y, hh.x, hh.y}; }
        { const int t = f >> 2, ks = f & 3;
          const v4u kf = *(const LAS v4u*)(lds + G_KDT + (32 * t + r32) * KP + (16 * ks + 8 * hi) * 2);
          *(v4u*)(KF + (((size_t)u * 16 + f) * 64 + lane) * 8) = kf; }
    }
    __syncthreads();
    {
        f32x16 o[2];
#pragma unroll
        for (int r = 0; r < 16; ++r) { o[0][r] = 0.f; o[1][r] = 0.f; }
        bf16x8 Bv[4];
#pragma unroll
        for (int ks = 0; ks < 4; ++ks) { Bv[ks] = *(const LAS bf16x8*)(lds + G_VT + (32 * w + r32) * KP + (16 * ks + 8 * hi) * 2);
            *(bf16x8*)(VF + (((size_t)u * 32 + w * 4 + ks) * 64 + lane) * 8) = Bv[ks]; }
#pragma unroll
        for (int it = 0; it < 2; ++it)
#pragma unroll
            for (int ks = 0; ks < 4; ++ks) { const bf16x8 A = *(const LAS bf16x8*)(lds + G_PS + (32 * it + r32) * KP + (16 * ks + 8 * hi) * 2); o[it] = MFMA32(A, Bv[ks], o[it]); }
#pragma unroll
        for (int it = 0; it < 2; ++it)
#pragma unroll
            for (int r = 0; r < 16; r += 2) {
                const unsigned pk = cvtpk(o[it][r], o[it][r + 1]);
                bf16* op = OI + (tok0 + 32 * it + crow(r, hi)) * 1024 + h * 256 + 32 * w + r32;
                op[0] = (bf16)(pk & 0xffffu); op[1024] = (bf16)(pk >> 16);
            }
    }
    __syncthreads();
}
constexpr int CH_SLOT = 49 * 1024;
DI void gla_chain_wg(int b, int h, int dvh, const bf16* QF, const bf16* KF, const bf16* VF, const float* ALg, bf16* OX, LAS unsigned char* lds, int wv) {
    const int tid = fresh_tid(wv), lane = tid & 63, r32 = lane & 31, hi = lane >> 5, w = wv;
    const unsigned lds0 = (unsigned)(size_t)lds;
    constexpr int NC = SEQ / 64;
    const bool active = w < 4;
    const int dvb = dvh * 4 + (w & 3);
    f32x16 S[4];
#pragma unroll
    for (int t = 0; t < 4; ++t)
#pragma unroll
        for (int r = 0; r < 16; ++r) S[t][r] = 0.f;
    f32x16 o[2];
#pragma unroll
    for (int r = 0; r < 16; ++r) { o[0][r] = 0.f; o[1][r] = 0.f; }
    const size_t u0 = (size_t)(b * 4 + h) * 256;
#define CH_DMA(cc, slot) do { const size_t u_ = u0 + (cc); const unsigned d_ = lds0 + (slot) * CH_SLOT; \
        attn_body::glds16(QF + (u_ * 16 + w) * 512 + lane * 8,                  (unsigned)__builtin_amdgcn_readfirstlane(d_ + w * 1024)); \
        attn_body::glds16(QF + (u_ * 16 + w + 8) * 512 + lane * 8,              (unsigned)__builtin_amdgcn_readfirstlane(d_ + (w + 8) * 1024)); \
        attn_body::glds16(KF + (u_ * 16 + w) * 512 + lane * 8,                  (unsigned)__builtin_amdgcn_readfirstlane(d_ + (16 + w) * 1024)); \
        attn_body::glds16(KF + (u_ * 16 + w + 8) * 512 + lane * 8,              (unsigned)__builtin_amdgcn_readfirstlane(d_ + (24 + w) * 1024)); \
        attn_body::glds16(VF + (u_ * 32 + dvh * 16 + w) * 512 + lane * 8,       (unsigned)__builtin_amdgcn_readfirstlane(d_ + (32 + w) * 1024)); \
        attn_body::glds16(VF + (u_ * 32 + dvh * 16 + w + 8) * 512 + lane * 8,   (unsigned)__builtin_amdgcn_readfirstlane(d_ + (40 + w) * 1024)); \
        attn_body::glds16(ALg + u_ * 256 + lane * 4,                            (unsigned)__builtin_amdgcn_readfirstlane(d_ + 48 * 1024)); } while (0)
    CH_DMA(0, 0);
    CH_DMA(1, 1);
    int slot = 0;
#pragma unroll 1
    for (int c = 0; c < NC; ++c) {
        if (c < 2 || c >= NC - 2) asm volatile("s_waitcnt vmcnt(0) lgkmcnt(0)\n\ts_barrier" ::: "memory");
        else if (active) asm volatile("s_waitcnt vmcnt(39) lgkmcnt(0)\n\ts_barrier" ::: "memory");
        else asm volatile("s_waitcnt vmcnt(7) lgkmcnt(0)\n\ts_barrier" ::: "memory");
        if (active && c > 0) {
            const size_t tokp = (size_t)b * SEQ + (size_t)(c - 1) * 64;
#pragma unroll
            for (int it = 0; it < 2; ++it)
#pragma unroll
                for (int r = 0; r < 16; r += 2) {
                    const unsigned pk = cvtpk(o[it][r], o[it][r + 1]);
                    bf16* op = OX + (tokp + 32 * it + crow(r, hi)) * 1024 + h * 256 + 32 * dvb + r32;
                    op[0] = (bf16)(pk & 0xffffu); op[1024] = (bf16)(pk >> 16);
                }
        }
        const int slot2 = (slot == 0) ? 2 : slot - 1;
        if (c + 2 < NC) CH_DMA(c + 2, slot2);
        if (active) {
            const LAS unsigned char* sl = lds + slot * CH_SLOT;
#pragma unroll
            for (int r = 0; r < 16; ++r) { o[0][r] = 0.f; o[1][r] = 0.f; }
#pragma unroll
            for (int t = 0; t < 4; ++t)
#pragma unroll
                for (int s = 0; s < 2; ++s) {
                    const bf16x8 Bs = pack_step(S[t], s);
                    const bf16x8 q0 = *(const LAS bf16x8*)(sl + (t * 2 + s) * 1024 + lane * 16), q1 = *(const LAS bf16x8*)(sl + (8 + t * 2 + s) * 1024 + lane * 16);
                    o[0] = MFMA32(q0, Bs, o[0]);
                    o[1] = MFMA32(q1, Bs, o[1]);
                }
            bf16x8 vf[4];
#pragma unroll
            for (int ks = 0; ks < 4; ++ks) vf[ks] = *(const LAS bf16x8*)(sl + (32 + (w & 3) * 4 + ks) * 1024 + lane * 16);
#pragma unroll
            for (int t = 0; t < 4; ++t) {
#pragma unroll
                for (int g = 0; g < 4; ++g) { const f32x4 al = *(const LAS f32x4*)(sl + 48 * 1024 + (32 * t + 8 * g + 4 * hi) * 4);
                    S[t][4 * g + 0] *= al.x; S[t][4 * g + 1] *= al.y; S[t][4 * g + 2] *= al.z; S[t][4 * g + 3] *= al.w; }
#pragma unroll
                for (int ks = 0; ks < 4; ++ks) { const bf16x8 kf = *(const LAS bf16x8*)(sl + (16 + t * 4 + ks) * 1024 + lane * 16); S[t] = MFMA32(kf, vf[ks], S[t]); }
            }
        }
        slot = (slot == 2) ? 0 : slot + 1;
    }
    if (active) {
        const size_t tokp = (size_t)b * SEQ + (size_t)(NC - 1) * 64;
#pragma unroll
        for (int it = 0; it < 2; ++it)
#pragma unroll
            for (int r = 0; r < 16; r += 2) {
                const unsigned pk = cvtpk(o[it][r], o[it][r + 1]);
                bf16* op = OX + (tokp + 32 * it + crow(r, hi)) * 1024 + h * 256 + 32 * dvb + r32;
                op[0] = (bf16)(pk & 0xffffu); op[1024] = (bf16)(pk >> 16);
            }
    }
#undef CH_DMA
    asm volatile("s_waitcnt vmcnt(0) lgkmcnt(0)\n\ts_barrier" ::: "memory");
}

DI void mem_unit(int b, int h, int qb, const bf16* proj, const bf16* mk, const bf16* mvT, bf16* mix, LAS unsigned char* lds, int wv) {
    const int tid = fresh_tid(wv), lane = tid & 63, r32 = lane & 31, hi = lane >> 5, w = __builtin_amdgcn_readfirstlane(tid >> 6);
    LAS unsigned char* Kms = lds; LAS unsigned char* VmT = lds + 65536;
#pragma unroll
    for (int i = 0; i < 8; ++i) { const int idx = tid + 512 * i, m = idx >> 4, c = idx & 15;
        const v4u v = *(const v4u*)(mk + (size_t)(b * 256 + m) * 512 + h * 128 + c * 8); *(LAS v4u*)(Kms + m * 256 + ((c ^ (m & 15)) * 16)) = v; }
#pragma unroll
    for (int i = 0; i < 8; ++i) { const int idx = tid + 512 * i, d = idx >> 5, c = idx & 31;
        const v4u v = *(const v4u*)(mvT + (size_t)((b * 4 + h) * 128 + d) * 256 + c * 8); *(LAS v4u*)(VmT + d * 512 + ((c ^ (d & 15)) * 16)) = v; }
    const size_t row0 = (size_t)b * SEQ + (size_t)qb * 256 + 32 * w;
    bf16x8 qf[8];
#pragma unroll
    for (int s = 0; s < 8; ++s) qf[s] = *(const bf16x8*)(proj + (row0 + r32) * PJ + C_MQ + h * 128 + 16 * s + 8 * hi);
    __syncthreads();
    const int sw = r32 & 15;
    float mx = -INFINITY;
#pragma unroll 1
    for (int kt = 0; kt < 8; ++kt) {
        f32x16 sT;
#pragma unroll
        for (int r = 0; r < 16; ++r) sT[r] = 0.f;
#pragma unroll
        for (int s = 0; s < 8; ++s) { const bf16x8 A = *(const LAS bf16x8*)(Kms + (32 * kt + r32) * 256 + (((2 * s + hi) ^ sw) * 16)); sT = MFMA32(A, qf[s], sT); }
#pragma unroll
        for (int r = 0; r < 16; ++r) mx = fmaxf(mx, sT[r]);
    }
    mx = fmaxf(mx, __shfl_xor(mx, 32));
    float l = 0.f;
    f32x16 o[4];
#pragma unroll
    for (int dt = 0; dt < 4; ++dt)
#pragma unroll
        for (int r = 0; r < 16; ++r) o[dt][r] = 0.f;
#pragma unroll 1
    for (int kt = 0; kt < 8; ++kt) {
        f32x16 sT;
#pragma unroll
        for (int r = 0; r < 16; ++r) sT[r] = 0.f;
#pragma unroll
        for (int s = 0; s < 8; ++s) { const bf16x8 A = *(const LAS bf16x8*)(Kms + (32 * kt + r32) * 256 + (((2 * s + hi) ^ sw) * 16)); sT = MFMA32(A, qf[s], sT); }
#pragma unroll
        for (int r = 0; r < 16; ++r) { sT[r] = __builtin_amdgcn_exp2f(sT[r] - mx); l += sT[r]; }
#pragma unroll
        for (int s2 = 0; s2 < 2; ++s2) {
            const bf16x8 Pa = pack_step(sT, s2);
            const int c0 = 4 * kt + 2 * s2;
#pragma unroll
            for (int dt = 0; dt < 4; ++dt) {
                const LAS unsigned char* vr = VmT + (32 * dt + r32) * 512 + 8 * hi;
                const s16x4 lo = *(const LAS s16x4*)(vr + ((c0 ^ sw) * 16)), hh = *(const LAS s16x4*)(vr + (((c0 + 1) ^ sw) * 16));
                const bf16x8 Bv = __builtin_shufflevector(lo, hh, 0, 1, 2, 3, 4, 5, 6, 7);
                o[dt] = MFMA32(Pa, Bv, o[dt]);
            }
        }
    }
    l += __shfl_xor(l, 32);
    volatile LAS float* wsf = (volatile LAS float*)(lds + WSF_OFF) + w * 64;
    if (hi == 0) wsf[r32] = 1.f / l;
    asm volatile("s_waitcnt lgkmcnt(0)" ::: "memory"); __builtin_amdgcn_wave_barrier();
    float rl[16];
#pragma unroll
    for (int r = 0; r < 16; ++r) rl[r] = wsf[crow(r, hi)];
#pragma unroll
    for (int dt = 0; dt < 4; ++dt)
#pragma unroll
        for (int r = 0; r < 16; ++r) {
            const size_t row = row0 + crow(r, hi); const int col = h * 128 + 32 * dt + r32;
            const float g = bf2f(proj[row * PJ + C_MG + col]);
            const unsigned pk = cvtpk(o[dt][r] * rl[r] * silu(g), 0.f);
            mix[row * DM + 1536 + col] = (bf16)(pk & 0xffffu);
        }
    __syncthreads();
}

DI void combine_pass(const Args& a, int bx, int G, int wv) {
    const int tid = fresh_tid(wv), lane = tid & 63, gw = bx * NWAVES + __builtin_amdgcn_readfirstlane(tid >> 6), NGW = G * NWAVES;
    const bf16* obuf = (const bf16*)(a.ws + WS_OBUF); const bf16* proj = (const bf16*)(a.ws + WS_PROJ); bf16* mix = (bf16*)(a.ws + WS_MIX);
    const float s1 = wave_sum(a.lq1[lane] * a.lk1[lane]), s2 = wave_sum(a.lq2[lane] * a.lk2[lane]);
    const float lam = expf(s1) - expf(s2) + LAM_INIT;
    const bf16* OI = (const bf16*)(a.ws + WS_OI); const bf16* OX = (const bf16*)(a.ws + WS_OX);
    const int l32 = lane & 31, hh = lane >> 5, l16 = lane & 15, hd = lane >> 4;
    const f32x4 gg0 = *(const f32x4*)(a.gla_g + 8 * l32), gg1 = *(const f32x4*)(a.gla_g + 8 * l32 + 4);
    const f32x4 dg0 = *(const f32x4*)(a.diff_g + 8 * l16) * (1.f - LAM_INIT), dg1 = *(const f32x4*)(a.diff_g + 8 * l16 + 4) * (1.f - LAM_INIT);
    for (int row = gw; row < M; row += NGW) {
#pragma unroll
        for (int p = 0; p < 2; ++p) {
            const int h = 2 * p + hh;
            const v4u oi = __builtin_nontemporal_load((const v4u*)(OI + (size_t)row * 1024 + h * 256 + 8 * l32)), ox = __builtin_nontemporal_load((const v4u*)(OX + (size_t)row * 1024 + h * 256 + 8 * l32));
            const v4u ug = __builtin_nontemporal_load((const v4u*)(proj + (size_t)row * PJ + C_GG + h * 256 + 8 * l32));
            float o[8];
            o[0] = bflo(oi.x) + bflo(ox.x); o[1] = bfhi(oi.x) + bfhi(ox.x); o[2] = bflo(oi.y) + bflo(ox.y); o[3] = bfhi(oi.y) + bfhi(ox.y);
            o[4] = bflo(oi.z) + bflo(ox.z); o[5] = bfhi(oi.z) + bfhi(ox.z); o[6] = bflo(oi.w) + bflo(ox.w); o[7] = bfhi(oi.w) + bfhi(ox.w);
            float ssq = (o[0] * o[0] + o[1] * o[1]) + (o[2] * o[2] + o[3] * o[3]) + (o[4] * o[4] + o[5] * o[5]) + (o[6] * o[6] + o[7] * o[7]);
            ssq += __shfl_xor(ssq, 1); ssq += __shfl_xor(ssq, 2); ssq += __shfl_xor(ssq, 4); ssq += __shfl_xor(ssq, 8); ssq += __shfl_xor(ssq, 16);
            const float rstd = rsqrtf(ssq * (1.f / 256.f) + GLA_EPS);
            v4u w;
            w.x = cvtpk(o[0] * rstd * gg0.x * silu(bflo(ug.x)), o[1] * rstd * gg0.y * silu(bfhi(ug.x)));
            w.y = cvtpk(o[2] * rstd * gg0.z * silu(bflo(ug.y)), o[3] * rstd * gg0.w * silu(bfhi(ug.y)));
            w.z = cvtpk(o[4] * rstd * gg1.x * silu(bflo(ug.z)), o[5] * rstd * gg1.y * silu(bfhi(ug.z)));
            w.w = cvtpk(o[6] * rstd * gg1.z * silu(bflo(ug.w)), o[7] * rstd * gg1.w * silu(bfhi(ug.w)));
            *(v4u*)(mix + (size_t)row * DM + h * 256 + 8 * l32) = w;
        }
        {
            const v4u u1 = __builtin_nontemporal_load((const v4u*)(obuf + (size_t)row * 1024 + hd * 256 + 8 * l16)), u2 = __builtin_nontemporal_load((const v4u*)(obuf + (size_t)row * 1024 + hd * 256 + 128 + 8 * l16));
            const v4u ug = __builtin_nontemporal_load((const v4u*)(proj + (size_t)row * PJ + C_DG + hd * 128 + 8 * l16));
            float d[8];
            d[0] = bflo(u1.x) - lam * bflo(u2.x); d[1] = bfhi(u1.x) - lam * bfhi(u2.x); d[2] = bflo(u1.y) - lam * bflo(u2.y); d[3] = bfhi(u1.y) - lam * bfhi(u2.y);
            d[4] = bflo(u1.z) - lam * bflo(u2.z); d[5] = bfhi(u1.z) - lam * bfhi(u2.z); d[6] = bflo(u1.w) - lam * bflo(u2.w); d[7] = bfhi(u1.w) - lam * bfhi(u2.w);
            float ssq = (d[0] * d[0] + d[1] * d[1]) + (d[2] * d[2] + d[3] * d[3]) + (d[4] * d[4] + d[5] * d[5]) + (d[6] * d[6] + d[7] * d[7]);
            ssq += __shfl_xor(ssq, 1); ssq += __shfl_xor(ssq, 2); ssq += __shfl_xor(ssq, 4); ssq += __shfl_xor(ssq, 8);
            const float rstd = rsqrtf(ssq * (1.f / 128.f) + DIFF_EPS);
            v4u w;
            w.x = cvtpk(d[0] * rstd * dg0.x * silu(bflo(ug.x)), d[1] * rstd * dg0.y * silu(bfhi(ug.x)));
            w.y = cvtpk(d[2] * rstd * dg0.z * silu(bflo(ug.y)), d[3] * rstd * dg0.w * silu(bfhi(ug.y)));
            w.z = cvtpk(d[4] * rstd * dg1.x * silu(bflo(ug.z)), d[5] * rstd * dg1.y * silu(bfhi(ug.z)));
            w.w = cvtpk(d[6] * rstd * dg1.z * silu(bflo(ug.w)), d[7] * rstd * dg1.w * silu(bfhi(ug.w)));
            *(v4u*)(mix + (size_t)row * DM + 1024 + hd * 128 + 8 * l16) = w;
        }
    }
}
DI void ln_pass(const Args& a, int bx, int G, int wv) {
    const int tid = fresh_tid(wv), lane = tid & 63, gw = bx * NWAVES + __builtin_amdgcn_readfirstlane(tid >> 6), NGW = G * NWAVES;
    const bf16* ob = (const bf16*)(a.ws + WS_OUTB);
    f32x4 lg[8], lb[8];
#pragma unroll
    for (int j = 0; j < 8; ++j) { lg[j] = ((const f32x4*)a.ln_g)[64 * j + lane]; lb[j] = ((const f32x4*)a.ln_b)[64 * j + lane]; }
    for (int row = gw; row < M; row += NGW) {
        const f32x4* xr = (const f32x4*)(a.x + (size_t)row * DM) + lane;
        const v2u* orow = (const v2u*)(ob + (size_t)row * DM) + lane;
        f32x4 v[8]; float s = 0.f;
#pragma unroll
        for (int j = 0; j < 8; ++j) { const f32x4 xv = __builtin_nontemporal_load(xr + 64 * j); const v2u o = __builtin_nontemporal_load(orow + 64 * j);
            v[j].x = xv.x * ALPHA + bflo(o.x); v[j].y = xv.y * ALPHA + bfhi(o.x); v[j].z = xv.z * ALPHA + bflo(o.y); v[j].w = xv.w * ALPHA + bfhi(o.y);
            s += (v[j].x + v[j].y) + (v[j].z + v[j].w); }
        const float mean = wave_sum(s) * (1.f / DM); float s2 = 0.f;
#pragma unroll
        for (int j = 0; j < 8; ++j) { v[j] = v[j] - mean; s2 += (v[j].x * v[j].x + v[j].y * v[j].y) + (v[j].z * v[j].z + v[j].w * v[j].w); }
        const float rstd = rsqrtf(wave_sum(s2) * (1.f / DM) + LN_EPS);
        f32x4* outr = (f32x4*)(a.out + (size_t)row * DM) + lane;
#pragma unroll
        for (int j = 0; j < 8; ++j) __builtin_nontemporal_store(v[j] * rstd * lg[j] + lb[j], outr + 64 * j);
    }
}

#define XB_TMO      128
#define XB_XCNT(j)  (256  + 64 * (j))
#define XB_XSUB(j)  (1280 + 64 * (j))
#define XB_XGEN(j)  (2304 + 64 * (j))
#define XB_TOP      3328
#define XB_TOPGEN   3392
#define XCD_BAR_WORDS 3456
#define XB_SPIN_CAP (1u << 18)

__device__ __forceinline__ unsigned xb_ld(unsigned* p)              { return __hip_atomic_load(p, __ATOMIC_RELAXED, __HIP_MEMORY_SCOPE_AGENT); }
__device__ __forceinline__ unsigned xb_add(unsigned* p, unsigned v) { return __hip_atomic_fetch_add(p, v, __ATOMIC_RELAXED, __HIP_MEMORY_SCOPE_AGENT); }
__device__ __forceinline__ unsigned xb_xcc_id() { return (unsigned)__builtin_amdgcn_s_getreg((3 << 11) | 20) & 0xFu; }
#define XB_SPIN(cond, bar) do { unsigned _sp = 0; while (cond) { __builtin_amdgcn_s_sleep(1); \
    if ((++_sp & 255u) == 0u) { if (xb_ld(&(bar)[XB_TMO])) break; if (_sp > XB_SPIN_CAP) { atomicAdd(&(bar)[XB_TMO], 1u); break; } } } } while (0)

struct XcdBarrier {
    unsigned* bar; unsigned x;
    volatile LAS unsigned* st;
};

__device__ __forceinline__ XcdBarrier xcd_barrier_post(unsigned* bar, volatile LAS unsigned* st, bool lead) {
    XcdBarrier b; b.bar = bar; b.x = xb_xcc_id(); b.st = st;
    if (lead) (void)xb_add(&bar[XB_XCNT(b.x)], 1u);
    return b;
}
__device__ __forceinline__ void xcd_barrier_complete(unsigned* bar, unsigned x, unsigned& nloc, unsigned& nx) {
    const unsigned G = gridDim.x * gridDim.y * gridDim.z;
    unsigned sum, cnt, mine, sp = 0u;
    for (;;) {
        sum = 0u; cnt = 0u; mine = 0u;
#pragma unroll
        for (unsigned j = 0; j < 16; ++j) { const unsigned c = xb_ld(&bar[XB_XCNT(j)]); sum += c; cnt += (c > 0u) ? 1u : 0u; mine = (j == x) ? c : mine; }
        if (sum == G) break;
        __builtin_amdgcn_s_sleep(1);
        if ((++sp & 255u) == 0u) { if (xb_ld(&bar[XB_TMO])) break; if (sp > XB_SPIN_CAP) { atomicAdd(&bar[XB_TMO], 1u); break; } }
    }
    nloc = mine > 0u ? mine : 1u; nx = cnt > 0u ? cnt : 1u;
}

__device__ __forceinline__ void xcd_barrier(const XcdBarrier& b, bool lead) {
    asm volatile("s_waitcnt vmcnt(0)" ::: "memory");
    __syncthreads();
    if (lead) {
        unsigned* bar = b.bar;
        __builtin_amdgcn_s_waitcnt(0);
        unsigned nloc = b.st[0], nx = b.st[1];
        if (nloc == 0u) { xcd_barrier_complete(bar, b.x, nloc, nx); b.st[0] = nloc; b.st[1] = nx; }
        const unsigned old = xb_add(&bar[XB_XSUB(b.x)], 1u);
        const unsigned gen = old / nloc;
        if (old + 1u == (gen + 1u) * nloc) {
            __builtin_amdgcn_fence(__ATOMIC_RELEASE, "agent");
            asm volatile("s_waitcnt vmcnt(0)" ::: "memory");
            const unsigned og = xb_add(&bar[XB_TOP], 1u);
            const unsigned tg = og / nx;
            if (og + 1u == (tg + 1u) * nx) xb_add(&bar[XB_TOPGEN], 1u);
            else XB_SPIN(xb_ld(&bar[XB_TOPGEN]) == tg, bar);
            __builtin_amdgcn_fence(__ATOMIC_ACQUIRE, "agent");
            xb_add(&bar[XB_XGEN(b.x)], 1u);
            asm volatile("s_waitcnt vmcnt(0)" ::: "memory");
        } else {
            XB_SPIN(xb_ld(&bar[XB_XGEN(b.x)]) == gen, bar);
            __builtin_amdgcn_fence(__ATOMIC_ACQUIRE, "agent");
            asm volatile("s_waitcnt vmcnt(0)" ::: "memory");
        }
    }
    __syncthreads();
}

#ifndef REP0
#define REP0 1
#endif
#ifndef REP1
#define REP1 1
#endif
#ifndef REP2
#define REP2 1
#endif
#ifndef REPM
#define REPM 1
#endif
#ifndef REPB
#define REPB 0
#endif
#ifndef REPA
#define REPA 1
#endif
#ifndef REPC
#define REPC 1
#endif
#ifndef REP4
#define REP4 1
#endif
#ifndef REP5
#define REP5 1
#endif
#ifndef REP6
#define REP6 1
#endif
constexpr int N_DIFF_UNITS = 2 * 8 * 64, N_MEM_UNITS = 2 * 4 * 64, N_UNITS = N_DIFF_UNITS + N_MEM_UNITS;
__global__ void __launch_bounds__(NWAVES * 64, 2) fwd_mega(Args a) {
    extern __shared__ __attribute__((aligned(16))) unsigned char lds[];
    LAS unsigned char* L = (LAS unsigned char*)lds;
    const int bx = blockIdx.x, G = gridDim.x;
    const int wv = __builtin_amdgcn_readfirstlane((int)threadIdx.x >> 6);
    unsigned char* ws = a.ws;
    const int lo = a.ph_lo, hi = a.ph_hi;
#define IN(k) (lo <= (k) && (k) < hi)
    volatile LAS unsigned* MISC = (volatile LAS unsigned*)(L + MISC_OFF);
    { const int t0 = fresh_tid(wv); if (t0 < 32) MISC[t0] = 0u; }
    __syncthreads();
    const XcdBarrier xbar = xcd_barrier_post((unsigned*)(ws + WS_CTL) + 1024, MISC + 8, a.coop && fresh_tid(wv) == 0);
    if (a.pad == 0x5eed) cg::this_grid().sync();
#define SEAM(k) do { if (IN(k) && IN((k) + 1)) xcd_barrier(xbar, fresh_tid(wv) == 0); } while (0)
    if (IN(0)) { for (int rep = 0; rep < REP0; ++rep) p0_prologue(a, L, bx, G, wv); }
    SEAM(0);
    if (IN(1)) for (int rep = 0; rep < REP1; ++rep) {
        { pg8::Gemm g{(const pg8::bf16_t*)(ws + WS_XB), (const pg8::bf16_t*)(ws + WS_WIN_T), M, PJ, DM}; pg8::StaticOrder S; S.init(M, PJ, G, bx);
          pg8::EpiProj E{(pg8::bf16_t*)(ws + WS_PROJ), (const float*)(ws + WS_CS)};
          pg8::gemm_phase<pg8::EpiProj, pg8::StaticOrder, PG8_ALIGN, PG8_SP2>(L, g, S, E, fresh_tid(wv)); }
    }
    SEAM(1);
    if (IN(2)) {
        for (int rep = 0; rep < REP2; ++rep) for (int u = bx; u < 2048; u += G)
            gla_pre(u, (const bf16*)(ws + WS_PROJ), (const float*)(ws + WS_GLR), a.w_gk_up, a.b_gk_up, (bf16*)(ws + WS_QF), (bf16*)(ws + WS_KF), (bf16*)(ws + WS_VF), (float*)(ws + WS_AL), (bf16*)(ws + WS_OI), L, wv);
    }
    SEAM(2);
    if (IN(3)) {
        unsigned* ctr = (unsigned*)(ws + WS_CTL);
        if (bx < 8) {
            { pg8::Gemm g{(const pg8::bf16_t*)(ws + WS_MEMB), (const pg8::bf16_t*)(ws + WS_WMKV_T), BATCH * NMEM, 1024, DM}; pg8::StaticOrder S; S.init(BATCH * NMEM, 1024, G, bx);
              pg8::EpiMkv E{(pg8::bf16_t*)(ws + WS_MK), (pg8::bf16_t*)(ws + WS_MVT)};
              pg8::gemm_phase<pg8::EpiMkv, pg8::StaticOrder, PG8_ALIGN, PG8_SP2>(L, g, S, E, fresh_tid(wv)); }
            __threadfence();
            __syncthreads();
            if (fresh_tid(wv) == 0) __hip_atomic_fetch_add(ctr + 128, 1u, __ATOMIC_RELEASE, __HIP_MEMORY_SCOPE_AGENT);
        }
        if (bx < 16) for (int rep = 0; rep < REPC; ++rep) gla_chain_wg(bx >> 3, (bx >> 1) & 3, bx & 1, (const bf16*)(ws + WS_QF), (const bf16*)(ws + WS_KF), (const bf16*)(ws + WS_VF), (const float*)(ws + WS_AL), (bf16*)(ws + WS_OX), L, wv);
        for (int rep = 0; rep < REPA; ++rep) {
            const int myq = (int)(xb_xcc_id() & 7u);
            for (int qi = 0; qi < 8; ++qi) {
                const int q = (myq + qi) & 7;
                unsigned* head = ctr + 4608 + 512 * rep + 64 * q;
                for (;;) {
                    __syncthreads();
                    if (fresh_tid(wv) == 0) MISC[0] = atomicAdd(head, 1u);
                    __syncthreads();
                    const int j = (int)MISC[0];
                    if (j >= 128) break;
                    const int qb = 63 - (j >> 1), b = j & 1, hc = q, h = hc >> 1;
                    const attn_body::bf16* P = (const attn_body::bf16*)(ws + WS_PROJ);
                    attn_body::attn_unit<8>(fresh_tid(wv), b, qb, P + C_DQ + hc * 64, P + C_DK + hc * 64, P + C_DV + h * 128,
                                            (attn_body::bf16*)(ws + WS_OBUF) + hc * 128, (char*)lds);
                }
            }
        }
        if (fresh_tid(wv) == 0) {
            unsigned sp = 0u;
            while (__hip_atomic_load(ctr + 128, __ATOMIC_ACQUIRE, __HIP_MEMORY_SCOPE_AGENT) < 8u) { __builtin_amdgcn_s_sleep(8); if (++sp > (1u << 22)) break; }
        }
        __syncthreads();
        __builtin_amdgcn_fence(__ATOMIC_ACQUIRE, "agent");
        for (int rep = 0; rep < REPM; ++rep) for (;;) {
            __syncthreads();
            if (fresh_tid(wv) == 0) MISC[0] = atomicAdd(ctr + 64 + 320 * rep, 1u);
            __syncthreads();
            const int u = (int)MISC[0];
            if (u >= N_MEM_UNITS) break;
            mem_unit(u >> 8, (u >> 6) & 3, u & 63, (const bf16*)(ws + WS_PROJ), (const bf16*)(ws + WS_MK), (const bf16*)(ws + WS_MVT), (bf16*)(ws + WS_MIX), L, wv);
        }
    }
    SEAM(3);
    if (IN(4)) for (int rep = 0; rep < REP4; ++rep) combine_pass(a, bx, G, wv);
    SEAM(4);
    if (IN(5)) for (int rep = 0; rep < REP5; ++rep) {
        pg8::Gemm g{(const pg8::bf16_t*)(ws + WS_MIX), (const pg8::bf16_t*)(ws + WS_WOUT_T), M, DM, DM}; pg8::StaticOrder S; S.init(M, DM, G, bx);
        pg8::EpiOutB E{(pg8::bf16_t*)(ws + WS_OUTB)};
        pg8::gemm_phase<pg8::EpiOutB, pg8::StaticOrder, PG8_ALIGN, PG8_SP2>(L, g, S, E, fresh_tid(wv));
    }
    SEAM(5);
    for (int rep = 0; rep < REPB; ++rep) xcd_barrier(xbar, fresh_tid(wv) == 0);
    if (IN(6)) for (int rep = 0; rep < REP6; ++rep) ln_pass(a, bx, G, wv);
#undef IN
#undef SEAM
}

#ifndef MK_N_LAUNCHES
#define MK_N_LAUNCHES 1
#endif
extern "C" void kernel_launch(void* const* d_in, const int* in_sizes, int n_in, void* d_out, int out_size, void* d_ws, size_t ws_size, hipStream_t stream) {
    static int grid = 0;
    if (grid == 0) {
        if (n_in != 16 || in_sizes[0] != M * DM || out_size != M * DM || ws_size < WS_END) { fprintf(stderr, "kernel_launch: unexpected shapes (n_in %d, in0 %d, out %d, ws %zu)\n", n_in, n_in > 0 ? in_sizes[0] : -1, out_size, ws_size); grid = -1; return; }
        int dev = 0, cus = 0, per_cu = 0;
        if (hipGetDevice(&dev) != hipSuccess || hipDeviceGetAttribute(&cus, hipDeviceAttributeMultiprocessorCount, dev) != hipSuccess) { grid = -1; return; }
        if (hipFuncSetAttribute((const void*)fwd_mega, hipFuncAttributeMaxDynamicSharedMemorySize, LDS_BYTES) != hipSuccess) { fprintf(stderr, "kernel_launch: hipFuncSetAttribute failed\n"); grid = -1; return; }
        if (hipOccupancyMaxActiveBlocksPerMultiprocessor(&per_cu, (const void*)fwd_mega, NWAVES * 64, LDS_BYTES) != hipSuccess || per_cu < 1) { fprintf(stderr, "kernel_launch: occupancy query says %d\n", per_cu); per_cu = 1; }
        (void)hipGetLastError();
        grid = cus;
    }
    if (grid < 0) return;
    (void)hipMemsetAsync((char*)d_ws + WS_CTL, 0, CTL_ZERO_BYTES, stream);
    Args a{};
    a.x = (const float*)d_in[0]; a.mem = (const float*)d_in[1]; a.pos = (const int*)d_in[2]; a.w_in = (const float*)d_in[3]; a.w_gk_up = (const float*)d_in[4]; a.b_gk_up = (const float*)d_in[5];
    a.gla_g = (const float*)d_in[6]; a.lq1 = (const float*)d_in[7]; a.lk1 = (const float*)d_in[8]; a.lq2 = (const float*)d_in[9]; a.lk2 = (const float*)d_in[10]; a.diff_g = (const float*)d_in[11];
    a.w_mkv = (const float*)d_in[12]; a.w_out = (const float*)d_in[13]; a.ln_g = (const float*)d_in[14]; a.ln_b = (const float*)d_in[15];
    a.out = (float*)d_out; a.ws = (unsigned char*)d_ws;
    for (int i = 0; i < 8; ++i) a.inv_freq[i] = (float)pow(500000.0, -(double)i / 8.0);
    a.pad = 0;
#if MK_N_LAUNCHES == 1
    a.ph_lo = 0; a.ph_hi = 7; a.coop = 1;
    void* args[] = {&a};
    hipError_t e = hipLaunchCooperativeKernel((const void*)fwd_mega, dim3(grid), dim3(NWAVES * 64), args, LDS_BYTES, stream);
    if (e != hipSuccess) fprintf(stderr, "kernel_launch: cooperative launch failed: %s (grid %d)\n", hipGetErrorString(e), grid);
#else
    for (int p = 0; p < 7; ++p) {
        a.ph_lo = p; a.ph_hi = p + 1; a.coop = 0;
        hipLaunchKernelGGL(fwd_mega, dim3(grid), dim3(NWAVES * 64), LDS_BYTES, stream, a);
    }
#endif
}
```

```cpp
#include <hip/hip_runtime.h>
#include <hip/hip_bf16.h>
#include <hip/hip_cooperative_groups.h>
#include <cstdio>
#include <cstdint>
#include <cmath>
namespace cg = cooperative_groups;
namespace pg8 {
#define PG8_LAS __attribute__((address_space(3)))
typedef unsigned short bf16_t;
typedef short bf16x8 __attribute__((ext_vector_type(8)));
typedef float f32x4 __attribute__((ext_vector_type(4)));
typedef unsigned u32x4 __attribute__((ext_vector_type(4)));
constexpr int BM = 256, BK = 64, HALF = 128, HTB = HALF * BK * 2  , STAGE_BYTES = 8 * HTB, NXCD = 8, WGM = 2;

__host__ __device__ __forceinline__ int lds_byte(int r, int c) { const int st = (r >> 4) * 2 + (c >> 5), rr = r & 15, cc = c & 31, ob = rr * 64 + cc * 2; return st * 1024 + (ob ^ (((ob >> 9) & 1) << 5)); }
__host__ __device__ __forceinline__ void stage_rc(int b, int& R, int& C) { const int st = b / 1024, sb = b % 1024, swz = sb ^ (((sb >> 9) & 1) << 5); R = (st >> 1) * 16 + swz / 64; C = (st & 1) * 32 + (swz % 64) / 2; }
__host__ __device__ __forceinline__ int perm32(int rho) { const int n = rho >> 4, i = rho & 15; return 8 * (i >> 2) + 4 * n + (i & 3); }

struct Unit { int pm, pn; };
struct Gemm { const bf16_t* A; const bf16_t* Bt; int M, N, K; };

struct StaticOrder {
    int nM, nN, nwg, G, c;
    __host__ __device__ void init(int M, int N, int G_, int c_) { nM = M / BM; nN = N / BM; nwg = nM * nN; G = G_; c = c_; }
    __host__ __device__ bool next(int i, Unit& u) const {
        const long L = (long)i * G + c; if (L >= nwg) return false;
        int wgid = (int)L; { const int q = nwg / NXCD, r = nwg % NXCD, xcd = wgid % NXCD, off = wgid / NXCD; wgid = (xcd < r ? xcd * (q + 1) : r * (q + 1) + (xcd - r) * q) + off; }
        const int nig = WGM * nN, gid = wgid / nig, fm = gid * WGM, gsz = (nM - fm) < WGM ? (nM - fm) : WGM;
        u.pm = fm + ((wgid % nig) % gsz); u.pn = (wgid % nig) / gsz; return true;
    }
    __device__ __forceinline__ void a_ready(const Unit&) const {}
    __device__ __forceinline__ void done(const Unit&) const {}
};

__device__ __forceinline__ unsigned cvt_pk_bf16(float lo, float hi) { unsigned r; asm volatile("v_cvt_pk_bf16_f32 %0, %1, %2" : "=v"(r) : "v"(lo), "v"(hi)); return r; }
typedef float f32x2 __attribute__((ext_vector_type(2)));
struct EpiProj {
    static constexpr bool PERM = true, AFTER_DRAIN = false;
    bf16_t* O; const float* cs;
    __device__ __forceinline__ void operator()(const f32x4 (&acc)[2][2][4][2], const Unit& u, int wr, int wc, int fr, int fq) const {
        const int pn = u.pn;
        const int row0 = u.pm * BM + wr * 64 + fr;
        const int col0 = pn * BM + wc * 32 + 8 * fq;
        float sc = 1.f; bool rotm = false;
        if (pn < 2) sc = 0.08838834764831845f;
        else if (pn == 12 || pn == 13) { rotm = true; sc = 0.125f * 1.4426950408889634f; }
        else if (pn == 14 || pn == 15) { rotm = true; }
        else if (pn == 20 || pn == 21) sc = 0.08838834764831845f * 1.4426950408889634f;
        const bool rot = rotm && ((wc & 1) == 0);
#pragma unroll
        for (int ai = 0; ai < 2; ++ai)
#pragma unroll
            for (int m = 0; m < 4; ++m) {
                const int row = row0 + ai * HALF + m * 16;
                bf16_t* rowp = O + (size_t)row * 6144 + col0;
                f32x4 c0 = {1.f, 1.f, 1.f, 1.f}, c1 = c0, s0 = {0.f, 0.f, 0.f, 0.f}, s1 = s0;
                if (rot) { const f32x4* cp = (const f32x4*)(cs + (size_t)row * 16); c0 = cp[0]; c1 = cp[1]; s0 = cp[2]; s1 = cp[3]; }
#pragma unroll
                for (int bj = 0; bj < 2; ++bj) {
                    f32x4 v0 = acc[ai][bj][m][0], v1 = acc[ai][bj][m][1];
                    if (rot) {
                        f32x4 p0, p1;
#pragma unroll
                        for (int e = 0; e < 4; ++e) { p0[e] = __shfl_xor(v0[e], 16); p1[e] = __shfl_xor(v1[e], 16); }
                        if (fq == 0) { v0 = v0 * c0 - p0 * s0; v1 = v1 * c1 - p1 * s1; }
                        else if (fq == 1) { v0 = v0 * c0 + p0 * s0; v1 = v1 * c1 + p1 * s1; }
                    }
                    v0 = v0 * sc; v1 = v1 * sc;
                    u32x4 w; w.x = cvt_pk_bf16(v0[0], v0[1]); w.y = cvt_pk_bf16(v0[2], v0[3]); w.z = cvt_pk_bf16(v1[0], v1[1]); w.w = cvt_pk_bf16(v1[2], v1[3]);
                    *(u32x4*)(rowp + bj * HALF) = w;
                }
            }
    }
};
struct EpiMkv {
    static constexpr bool PERM = true, AFTER_DRAIN = false;
    bf16_t* mk; bf16_t* mvT;
    __device__ __forceinline__ void operator()(const f32x4 (&acc)[2][2][4][2], const Unit& u, int wr, int wc, int fr, int fq) const {
        const int row0 = u.pm * BM + wr * 64 + fr;
        const int col0 = u.pn * BM + wc * 32 + 8 * fq;
#pragma unroll
        for (int ai = 0; ai < 2; ++ai)
#pragma unroll
            for (int m = 0; m < 4; ++m) {
                const int row = row0 + ai * HALF + m * 16; const int b = row >> 8, mm = row & 255;
#pragma unroll
                for (int bj = 0; bj < 2; ++bj) {
                    const f32x4 v0 = acc[ai][bj][m][0], v1 = acc[ai][bj][m][1];
                    const int col = col0 + bj * HALF;
                    u32x4 w; w.x = cvt_pk_bf16(v0[0], v0[1]); w.y = cvt_pk_bf16(v0[2], v0[3]); w.z = cvt_pk_bf16(v1[0], v1[1]); w.w = cvt_pk_bf16(v1[2], v1[3]);
                    if (col < 512) { *(u32x4*)(mk + (size_t)row * 512 + col) = w; }
                    else {
                        const int c2 = col - 512, hh = c2 >> 7, d = c2 & 127;
                        bf16_t* p = mvT + ((size_t)((b * 4 + hh) * 128 + d)) * 256 + mm;
                        p[0 * 256] = (bf16_t)(w.x & 0xffffu); p[1 * 256] = (bf16_t)(w.x >> 16);
                        p[2 * 256] = (bf16_t)(w.y & 0xffffu); p[3 * 256] = (bf16_t)(w.y >> 16);
                        p[4 * 256] = (bf16_t)(w.z & 0xffffu); p[5 * 256] = (bf16_t)(w.z >> 16);
                        p[6 * 256] = (bf16_t)(w.w & 0xffffu); p[7 * 256] = (bf16_t)(w.w >> 16);
                    }
                }
            }
    }
};
struct EpiY {
    static constexpr bool PERM = false, AFTER_DRAIN = false;
    const float* x; float* out; float alpha;
    __device__ __forceinline__ void operator()(const f32x4 (&acc)[2][2][4][2], const Unit& u, int wr, int wc, int fr, int fq) const {
        const int row0 = u.pm * BM + wr * 64 + fr;
        const int col0 = u.pn * BM + wc * 32 + 4 * fq;
#pragma unroll
        for (int ai = 0; ai < 2; ++ai)
#pragma unroll
            for (int m = 0; m < 4; ++m) {
                const size_t off = (size_t)(row0 + ai * HALF + m * 16) * 2048 + col0;
#pragma unroll
                for (int bj = 0; bj < 2; ++bj)
#pragma unroll
                    for (int n = 0; n < 2; ++n) {
                        const f32x4 xv = *(const f32x4*)(x + off + bj * HALF + n * 16);
                        *(f32x4*)(out + off + bj * HALF + n * 16) = xv * alpha + acc[ai][bj][m][n];
                    }
            }
    }
};
struct EpiOutB {
    static constexpr bool PERM = true, AFTER_DRAIN = false;
    bf16_t* O;
    __device__ __forceinline__ void operator()(const f32x4 (&acc)[2][2][4][2], const Unit& u, int wr, int wc, int fr, int fq) const {
        const int row0 = u.pm * BM + wr * 64 + fr;
        const int col0 = u.pn * BM + wc * 32 + 8 * fq;
#pragma unroll
        for (int ai = 0; ai < 2; ++ai)
#pragma unroll
            for (int m = 0; m < 4; ++m) {
                bf16_t* rowp = O + (size_t)(row0 + ai * HALF + m * 16) * 2048 + col0;
#pragma unroll
                for (int bj = 0; bj < 2; ++bj) {
                    const f32x4 v0 = acc[ai][bj][m][0], v1 = acc[ai][bj][m][1];
                    u32x4 w; w.x = cvt_pk_bf16(v0[0], v0[1]); w.y = cvt_pk_bf16(v0[2], v0[3]); w.z = cvt_pk_bf16(v1[0], v1[1]); w.w = cvt_pk_bf16(v1[2], v1[3]);
                    *(u32x4*)(rowp + bj * HALF) = w;
                }
            }
    }
};
template <class Epi, class Sched, bool ALIGN_EPI = false, bool SP2 = false>
__device__ __forceinline__ void gemm_phase(PG8_LAS unsigned char* lds, const Gemm g, const Sched& S, const Epi& E, const int tid) {
    const int wid = __builtin_amdgcn_readfirstlane(tid >> 6), lane = tid & 63, wr = wid >> 2, wc = wid & 3, fr = lane & 15, fq = lane >> 4;
    const int K = g.K, nt = K / BK;
    unsigned voffA[2], voffB[2];
#pragma unroll
    for (int i = 0; i < 2; ++i) { int R, C; stage_rc(tid * 16 + i * 8192, R, C); const int Rb = Epi::PERM ? ((R & ~31) + perm32(R & 31)) : R;
        voffA[i] = (unsigned)(R * K + C) * 2u; voffB[i] = (unsigned)(Rb * K + C) * 2u; }
    const size_t kstep = (size_t)(BK * 2);
    const size_t hstep = (size_t)HALF * K * 2;
    const size_t tstep = 2 * hstep;
    const unsigned ldsw = (unsigned)wid * 1024u;
    const int aoff = lds_byte(wr * 64 + fr, fq * 8), boff = lds_byte(wc * 32 + fr, fq * 8);
#define PG8_SA(b, h) (((b) * 2 + (h)) * HTB)
#define PG8_SB(b, h) ((4 + (b) * 2 + (h)) * HTB)
#define PG8_STAGE(bufoff, gbase, voff) do { _Pragma("unroll") for (int _i = 0; _i < 2; ++_i) \
        __builtin_amdgcn_global_load_lds((const unsigned*)((const char*)(gbase) + (voff)[_i]), (PG8_LAS unsigned*)(lds + (bufoff) + ldsw + _i * 8192), 16, 0, 0); } while (0)
#define PG8_LDA(dst, b, h) do { _Pragma("unroll") for (int m = 0; m < 4; ++m) _Pragma("unroll") for (int k = 0; k < 2; ++k) dst[m][k] = *(const PG8_LAS bf16x8*)(lds + PG8_SA(b, h) + aoff + m * 2048 + k * 1024); } while (0)
#define PG8_LDB(dst, b, h) do { _Pragma("unroll") for (int n = 0; n < 2; ++n) _Pragma("unroll") for (int k = 0; k < 2; ++k) dst[n][k] = *(const PG8_LAS bf16x8*)(lds + PG8_SB(b, h) + boff + n * 2048 + k * 1024); } while (0)
#define PG8_MMA(ai, bj, At, Bt) do { __builtin_amdgcn_s_setprio(1); _Pragma("unroll") for (int m = 0; m < 4; ++m) _Pragma("unroll") for (int n = 0; n < 2; ++n) _Pragma("unroll") for (int k = 0; k < 2; ++k) \
        acc[ai][bj][m][n] = __builtin_amdgcn_mfma_f32_16x16x32_bf16(Bt[n][k], At[m][k], acc[ai][bj][m][n], 0, 0, 0); __builtin_amdgcn_s_setprio(0); } while (0)
#define PG8_WAIT_V(n) asm volatile("s_waitcnt vmcnt(" #n ")" ::: "memory")
#define PG8_WAIT_L(n) asm volatile("s_waitcnt lgkmcnt(" #n ")" ::: "memory")
#define PG8_BAR __builtin_amdgcn_s_barrier()
#define PG8_SCHED __builtin_amdgcn_sched_barrier(0)
    Unit cur, nxt; int ui = 0;
    if (!S.next(0, cur)) return;
    f32x4 acc[2][2][4][2];
#pragma unroll
    for (int a = 0; a < 2; ++a)
#pragma unroll
        for (int b = 0; b < 2; ++b)
#pragma unroll
            for (int m = 0; m < 4; ++m)
#pragma unroll
                for (int n = 0; n < 2; ++n) acc[a][b][m][n] = (f32x4){0.f, 0.f, 0.f, 0.f};
    bf16x8 At[4][2], B0[2][2], B1[2][2];
    const char* cA = (const char*)g.A + (size_t)cur.pm * tstep; const char* cB = (const char*)g.Bt + (size_t)cur.pn * tstep;
    S.a_ready(cur);
    if constexpr (SP2) {
        PG8_STAGE(PG8_SB(0, 0), cB, voffB); PG8_STAGE(PG8_SB(0, 1), cB + hstep, voffB); PG8_STAGE(PG8_SA(0, 0), cA, voffA); PG8_STAGE(PG8_SA(0, 1), cA + hstep, voffA);
        if (wr == 1) PG8_BAR;
        PG8_WAIT_V(2); PG8_BAR;
        PG8_STAGE(PG8_SB(1, 0), cB + kstep, voffB); PG8_STAGE(PG8_SA(1, 0), cA + kstep, voffA); PG8_STAGE(PG8_SB(1, 1), cB + hstep + kstep, voffB);
        PG8_WAIT_V(6); PG8_BAR;
    } else {
        PG8_STAGE(PG8_SB(0, 0), cB, voffB); PG8_STAGE(PG8_SA(0, 0), cA, voffA); PG8_STAGE(PG8_SB(0, 1), cB + hstep, voffB); PG8_STAGE(PG8_SA(0, 1), cA + hstep, voffA);
        if (wr == 1) PG8_BAR;
        PG8_WAIT_V(4); PG8_BAR;
        PG8_STAGE(PG8_SB(1, 0), cB + kstep, voffB); PG8_STAGE(PG8_SA(1, 0), cA + kstep, voffA); PG8_STAGE(PG8_SB(1, 1), cB + hstep + kstep, voffB);
        PG8_WAIT_V(6); PG8_BAR;
    }
    for (;;) {
        const bool has_next = S.next(ui + 1, nxt);
        const char* nA = has_next ? (const char*)g.A + (size_t)nxt.pm * tstep : cA; const char* nB = has_next ? (const char*)g.Bt + (size_t)nxt.pn * tstep : cB;
        for (int t = 0; t < nt; t += 2) {
            const bool last = (t == nt - 2);
            const char* a1 = cA + (size_t)(t + 1) * kstep;
            const char* a2 = last ? nA : cA + (size_t)(t + 2) * kstep; const char* b2 = last ? nB : cB + (size_t)(t + 2) * kstep;
            const char* a3 = a2 + kstep; const char* b3 = b2 + kstep;
            if (last && has_next) S.a_ready(nxt);
            if constexpr (SP2) {
            PG8_LDB(B0, 0, 0); PG8_LDB(B1, 0, 1); PG8_SCHED; PG8_LDA(At, 0, 0); PG8_STAGE(PG8_SA(1, 1), a1 + hstep, voffA);
            PG8_WAIT_V(8); PG8_WAIT_L(0); PG8_BAR; PG8_MMA(0, 0, At, B0); PG8_MMA(0, 1, At, B1); PG8_BAR; PG8_SCHED;
            PG8_LDA(At, 0, 1); PG8_STAGE(PG8_SB(0, 0), b2, voffB); PG8_STAGE(PG8_SB(0, 1), b2 + hstep, voffB); PG8_STAGE(PG8_SA(0, 0), a2, voffA);
            PG8_WAIT_V(8); PG8_WAIT_L(0); PG8_BAR; PG8_MMA(1, 0, At, B0); PG8_MMA(1, 1, At, B1); PG8_BAR; PG8_SCHED;
            PG8_LDB(B0, 1, 0); PG8_LDB(B1, 1, 1); PG8_SCHED; PG8_LDA(At, 1, 0); PG8_STAGE(PG8_SA(0, 1), a2 + hstep, voffA);
            PG8_WAIT_V(8); PG8_WAIT_L(0); PG8_BAR; PG8_MMA(0, 0, At, B0); PG8_MMA(0, 1, At, B1); PG8_BAR; PG8_SCHED;
            PG8_LDA(At, 1, 1); PG8_STAGE(PG8_SB(1, 0), b3, voffB); PG8_STAGE(PG8_SB(1, 1), b3 + hstep, voffB); PG8_STAGE(PG8_SA(1, 0), a3, voffA);
            PG8_WAIT_V(8); PG8_WAIT_L(0); PG8_BAR; PG8_MMA(1, 0, At, B0); PG8_MMA(1, 1, At, B1); PG8_BAR; PG8_SCHED;
            } else {
            PG8_LDB(B0, 0, 0); PG8_SCHED; PG8_LDA(At, 0, 0); PG8_STAGE(PG8_SA(1, 1), a1 + hstep, voffA);
            PG8_WAIT_L(8); PG8_BAR; PG8_WAIT_L(0); PG8_MMA(0, 0, At, B0); PG8_BAR; PG8_SCHED;
            PG8_LDB(B1, 0, 1); PG8_STAGE(PG8_SB(0, 0), b2, voffB);
            PG8_BAR; PG8_WAIT_L(0); PG8_MMA(0, 1, At, B1); PG8_BAR;
            PG8_LDA(At, 0, 1); PG8_STAGE(PG8_SA(0, 0), a2, voffA);
            PG8_BAR; PG8_WAIT_L(0); PG8_MMA(1, 0, At, B0); PG8_BAR; PG8_SCHED;
            PG8_STAGE(PG8_SB(0, 1), b2 + hstep, voffB);
            PG8_WAIT_V(6); PG8_BAR; PG8_MMA(1, 1, At, B1); PG8_BAR;
            PG8_LDB(B0, 1, 0); PG8_SCHED; PG8_LDA(At, 1, 0); PG8_STAGE(PG8_SA(0, 1), a2 + hstep, voffA);
            PG8_WAIT_L(8); PG8_BAR; PG8_WAIT_L(0); PG8_MMA(0, 0, At, B0); PG8_BAR; PG8_SCHED;
            PG8_LDB(B1, 1, 1); PG8_STAGE(PG8_SB(1, 0), b3, voffB);
            PG8_BAR; PG8_WAIT_L(0); PG8_MMA(0, 1, At, B1); PG8_BAR;
            PG8_LDA(At, 1, 1); PG8_STAGE(PG8_SA(1, 0), a3, voffA);
            PG8_BAR; PG8_WAIT_L(0); PG8_MMA(1, 0, At, B0); PG8_BAR; PG8_SCHED;
            PG8_STAGE(PG8_SB(1, 1), b3 + hstep, voffB);
            PG8_WAIT_V(6); PG8_BAR; PG8_MMA(1, 1, At, B1); PG8_BAR;
            }
        }
        if constexpr (ALIGN_EPI) { if (wr == 0) PG8_BAR; }
        if constexpr (!Epi::AFTER_DRAIN) { E(acc, cur, wr, wc, fr, fq); S.done(cur); }
        if (!has_next) break;
#pragma unroll
        for (int a = 0; a < 2; ++a)
#pragma unroll
            for (int b = 0; b < 2; ++b)
#pragma unroll
                for (int m = 0; m < 4; ++m)
#pragma unroll
                    for (int n = 0; n < 2; ++n) acc[a][b][m][n] = (f32x4){0.f, 0.f, 0.f, 0.f};
        cur = nxt; cA = nA; cB = nB; ++ui;
        if constexpr (ALIGN_EPI) { if (wr == 1) PG8_BAR; }
    }
    PG8_WAIT_V(0);
    if constexpr (!ALIGN_EPI) { if (wr == 0) PG8_BAR; }
    PG8_BAR;
    if constexpr (Epi::AFTER_DRAIN) { E.fused(acc, cur, wr, wc, fr, fq, lds, wid, lane); S.done(cur); }
#undef PG8_SA
#undef PG8_SB
#undef PG8_STAGE
#undef PG8_LDA
#undef PG8_LDB
#undef PG8_MMA
#undef PG8_WAIT_V
#undef PG8_WAIT_L
#undef PG8_BAR
#undef PG8_SCHED
}
}

#ifndef PG8_SP2
#define PG8_SP2 true
#endif
#ifndef PG8_ALIGN
#define PG8_ALIGN true
#endif
namespace attn_body {
using bf16=__hip_bfloat16;
using bf16x8=__attribute__((ext_vector_type(8)))short;
using s16x4=__attribute__((ext_vector_type(4)))short;
using f32x16=__attribute__((ext_vector_type(16)))float;
using u32x4=__attribute__((ext_vector_type(4)))unsigned;
constexpr int SEQ=16384,D=64,PQ=6144,PO=1024;
constexpr int NW=8,QBLK=32,QB=QBLK*NW,KVBLK=64,NQB=SEQ/QB;
constexpr int ATTN_UNIT_ROWS=QB;
__device__ __forceinline__ int crow(int r,int hi){return (r&3)+8*(r>>2)+4*hi;}
#define SBAR() __builtin_amdgcn_sched_barrier(0)
__device__ __forceinline__ void cmask(f32x16&p0,f32x16&p1,int jb,int qrel,int hi){
  const float NEG=-INFINITY; int kb=64*jb+4*hi;
  #pragma unroll
  for(int r=0;r<16;++r){int kv=kb+(r&3)+8*(r>>2); if(kv>qrel)p0[r]=NEG; if(kv+32>qrel)p1[r]=NEG;}
}

constexpr int NSLOT=3, SLOTB=8192;
constexpr int LDS_K=0, LDS_V=NSLOT*SLOTB, LDS_WS=3*NSLOT*SLOTB, LDS_OST=LDS_WS+NW*64*4, LDS_Q=LDS_OST+NW*4096, LDS_BYTES=LDS_Q+NW*4096;
constexpr float C2=0.125f*1.4426950408889634f;
__device__ __forceinline__ void glds16(const void*gsrc,unsigned lds_dst){unsigned keep;
  asm volatile("s_mov_b32 %0, m0\n\ts_mov_b32 m0, %2\n\ts_nop 0\n\tglobal_load_lds_dwordx4 %1, off\n\ts_mov_b32 m0, %0":"=&s"(keep):"v"(gsrc),"s"(lds_dst):"memory");}
__device__ __forceinline__ void glds16nt(const void*gsrc,unsigned lds_dst){unsigned keep;
  asm volatile("s_mov_b32 %0, m0\n\ts_mov_b32 m0, %2\n\ts_nop 0\n\tglobal_load_lds_dwordx4 %1, off nt\n\ts_mov_b32 m0, %0":"=&s"(keep):"v"(gsrc),"s"(lds_dst):"memory");}
__device__ __forceinline__ void glds16s(const void*sbase,unsigned voff,unsigned lds_dst){unsigned keep;
  asm volatile("s_mov_b32 %0, m0\n\ts_mov_b32 m0, %3\n\ts_nop 0\n\tglobal_load_lds_dwordx4 %1, %2\n\ts_mov_b32 m0, %0":"=&s"(keep):"v"(voff),"s"(sbase),"s"(lds_dst):"memory");}
__device__ __forceinline__ float max3f(float a,float b,float c){float r;asm("v_max3_f32 %0, %1, %2, %3":"=v"(r):"v"(a),"v"(b),"v"(c));return r;}
__device__ __forceinline__ float max2f(float a,float b){float r;asm("v_max_f32_e32 %0, %1, %2":"=v"(r):"v"(a),"v"(b));return r;}
__device__ __forceinline__ float fadd_s(float a,float b){float r;asm("v_add_f32_e32 %0, %1, %2":"=v"(r):"v"(a),"v"(b));return r;}
__device__ __forceinline__ float fsub_s(float a,float b){float r;asm("v_sub_f32_e32 %0, %1, %2":"=v"(r):"v"(a),"v"(b));return r;}
typedef float f32x2_t __attribute__((ext_vector_type(2))); typedef __bf16 bf16x2_t __attribute__((ext_vector_type(2)));
__device__ __forceinline__ unsigned cvtpk_s(float lo,float hi){f32x2_t v={lo,hi};bf16x2_t b=__builtin_convertvector(v,bf16x2_t);return __builtin_bit_cast(unsigned,b);}
#define WAIT_BAR(N) asm volatile("s_waitcnt vmcnt(" #N ") lgkmcnt(0)\n\ts_barrier":::"memory")

__device__ __forceinline__ void qkt(f32x16&p0,f32x16&p1,const char*Kslot,const bf16x8*qr,const f32x16&negm,int r32,int hi){
  const char*kb=Kslot+hi*1024+r32*16;
  #pragma unroll
  for(int d0=0;d0<4;++d0){
    const bf16x8 b0=*reinterpret_cast<const bf16x8*>(kb+d0*2048);
    const bf16x8 b1=*reinterpret_cast<const bf16x8*>(kb+d0*2048+512);
    if(d0==0){p0=__builtin_amdgcn_mfma_f32_32x32x16_bf16(b0,qr[0],negm,0,0,0);p1=__builtin_amdgcn_mfma_f32_32x32x16_bf16(b1,qr[0],negm,0,0,0);}
    else{p0=__builtin_amdgcn_mfma_f32_32x32x16_bf16(b0,qr[d0],p0,0,0,0);p1=__builtin_amdgcn_mfma_f32_32x32x16_bf16(b1,qr[d0],p1,0,0,0);}}
}
typedef __attribute__((address_space(3))) const char* lds_cptr;
typedef short v4i16_t __attribute__((ext_vector_type(4)));
__device__ __forceinline__ void kload8(bf16x8*kf,lds_cptr kp){
  kf[0]=*(const __attribute__((address_space(3))) bf16x8*)(kp);      kf[1]=*(const __attribute__((address_space(3))) bf16x8*)(kp+512);
  kf[2]=*(const __attribute__((address_space(3))) bf16x8*)(kp+2048); kf[3]=*(const __attribute__((address_space(3))) bf16x8*)(kp+2560);
  kf[4]=*(const __attribute__((address_space(3))) bf16x8*)(kp+4096); kf[5]=*(const __attribute__((address_space(3))) bf16x8*)(kp+4608);
  kf[6]=*(const __attribute__((address_space(3))) bf16x8*)(kp+6144); kf[7]=*(const __attribute__((address_space(3))) bf16x8*)(kp+6656);
}
__device__ __forceinline__ void kload2(bf16x8*kf,lds_cptr kp,int j){ kf[2*j]=*(const __attribute__((address_space(3))) bf16x8*)(kp+j*2048); kf[2*j+1]=*(const __attribute__((address_space(3))) bf16x8*)(kp+j*2048+512); }
__device__ __forceinline__ s16x4 vtr(lds_cptr p){ return __builtin_bit_cast(s16x4,__builtin_amdgcn_ds_read_tr16_b64_v4i16((__attribute__((address_space(3))) v4i16_t*)p)); }
__device__ __forceinline__ float rowmax(const f32x16&p0,const f32x16&p1){
  float a=max3f(p0[0],p0[1],p1[0]),b=max3f(p0[2],p0[3],p1[1]);a=max3f(a,p1[2],p1[3]);
  #pragma unroll
  for(int r=4;r<16;r+=4){a=max3f(a,p0[r],p0[r+1]);b=max3f(b,p0[r+2],p0[r+3]);a=max3f(a,p1[r],p1[r+1]);b=max3f(b,p1[r+2],p1[r+3]);}
  const float m=max2f(a,b);
  auto rr=__builtin_amdgcn_permlane32_swap(__float_as_uint(m),__float_as_uint(m),false,false);
  return max2f(__uint_as_float(rr[0]),__uint_as_float(rr[1]));
}
__device__ __forceinline__ void pv(f32x16*o,int vb,bf16x8 pa0,bf16x8 pa1,bf16x8 pa2,bf16x8 pa3){
  #pragma unroll
  for(int d0=0;d0<2;++d0){s16x4 lo[4],hi[4];
    #pragma unroll
    for(int ks=0;ks<4;++ks){
      asm volatile("ds_read_b64_tr_b16 %0,%1 offset:%c2":"=&v"(lo[ks]):"v"(vb),"i"(d0*4096+ks*1024):"memory");
      asm volatile("ds_read_b64_tr_b16 %0,%1 offset:%c2":"=&v"(hi[ks]):"v"(vb),"i"(d0*4096+ks*1024+512):"memory");}
    asm volatile("s_waitcnt lgkmcnt(0)":::"memory");SBAR();
    #define PK(k) (bf16x8){lo[k][0],lo[k][1],lo[k][2],lo[k][3],hi[k][0],hi[k][1],hi[k][2],hi[k][3]}
    o[d0]=__builtin_amdgcn_mfma_f32_32x32x16_bf16(pa0,PK(0),o[d0],0,0,0);
    o[d0]=__builtin_amdgcn_mfma_f32_32x32x16_bf16(pa1,PK(1),o[d0],0,0,0);
    o[d0]=__builtin_amdgcn_mfma_f32_32x32x16_bf16(pa2,PK(2),o[d0],0,0,0);
    o[d0]=__builtin_amdgcn_mfma_f32_32x32x16_bf16(pa3,PK(3),o[d0],0,0,0);
    #undef PK
  }
}

#ifndef ATTN_STORE16
#define ATTN_STORE16(p,v) (*(u32x4*)(p)=(v))
#endif
template<int THRL> __device__ __forceinline__ void attn_unit(const int tid,int b,int qb,const bf16*Q,const bf16*__restrict__ K,const bf16*__restrict__ V,bf16*O,char*shm){
  const int lane=tid&63,r32=lane&31,hi=lane>>5; const int wid=__builtin_amdgcn_readfirstlane(tid>>6);
  const long rowbase=(long)b*SEQ; const int q0=qb*QB;
  const bf16*Qw=Q+(rowbase+q0+wid*QBLK)*PQ;
  const bf16*Kh=K+rowbase*PQ,*Vh=V+rowbase*PQ;
  const unsigned lds0=(unsigned)(uintptr_t)shm;
  float*wsf=(float*)(shm+LDS_WS)+wid*64;
  const unsigned koff=(unsigned)((lane*PQ+wid*8)*2);
  const unsigned voff=(unsigned)(((16*(wid&3)+(lane>>2))*PQ+(wid>>2)*32+(lane&3)*8)*2);
  const unsigned kdst=lds0+LDS_K+wid*1024, vdst=lds0+LDS_V+wid*1024;
  #define DMA_K(t,slot) glds16s(Kh+(long)(t)*KVBLK*PQ,koff,(unsigned)__builtin_amdgcn_readfirstlane(kdst+(slot)))
  #define DMA_V(t,slot) do{ glds16s(Vh+(long)(t)*KVBLK*PQ,voff,(unsigned)__builtin_amdgcn_readfirstlane(vdst+2*(slot))); glds16s(Vh+64+(long)(t)*KVBLK*PQ,voff,(unsigned)__builtin_amdgcn_readfirstlane(vdst+2*(slot)+8192)); }while(0)
  const int vb0=(int)(lds0+LDS_V)+((lane>>4)&1)*32+(lane&3)*8+(4*hi+((lane&15)>>2))*64;
  const char*Kbase=shm+LDS_K; bf16x8 kf[8];
  const lds_cptr shm3=(lds_cptr)shm; const lds_cptr kp0=shm3+LDS_K+hi*1024+r32*16; const lds_cptr vp0=shm3+LDS_V+((lane>>4)&1)*32+(lane&3)*8+(4*hi+((lane&15)>>2))*64;
  const int NT=(q0+QB)/KVBLK;
  DMA_K(0,0);DMA_V(0,0);DMA_K(1,SLOTB);
  bf16x8 qr[4];
  #pragma unroll
  for(int d0=0;d0<4;++d0)qr[d0]=*reinterpret_cast<const bf16x8*>(&Qw[(long)r32*PQ+d0*16+hi*8]);
  float mhat=0.f,l_reg=0.f;f32x16 o[4];o[0]=f32x16{};o[1]=f32x16{};o[2]=f32x16{};o[3]=f32x16{};const f32x16 zero16=f32x16{};
  const int qrel=wid*QBLK+r32;
  #define CMASK(P0,P1,t) do{int jb_=(t)-(NT-4); if(jb_>=0)cmask(P0,P1,jb_,qrel,hi);}while(0)
  bool resc=false;
  #define START(P0,P1) do{ const float rm=rowmax(P0,P1); resc=false; \
    { const float dl=rm; mhat=fadd_s(mhat,dl); \
      _Pragma("unroll") for(int r=0;r<16;++r){P0[r]=fsub_s(P0[r],dl);P1[r]=fsub_s(P1[r],dl);} \
      } \
    _Pragma("unroll") for(int r=0;r<16;++r)P0[r]=__builtin_amdgcn_exp2f(P0[r]); }while(0)
  #define RESC() do{ if(resc){ asm volatile("s_waitcnt lgkmcnt(0)":::"memory"); \
      _Pragma("unroll") for(int d_=0;d_<4;++d_) _Pragma("unroll") for(int r=0;r<16;++r)o[d_][r]*=wsf[crow(r,hi)]; } }while(0)
  f32x16 pA0,pA1,pB0,pB1;
  int sl_prev=0,sl_cur=0,sl_next=SLOTB;
  #define ROT() do{sl_prev=sl_cur;sl_cur=sl_next;sl_next=(sl_next==(NSLOT-1)*SLOTB)?0:sl_next+SLOTB;}while(0)
  DMA_K(2,2*SLOTB);
  WAIT_BAR(4);
  qkt(pA0,pA1,Kbase,qr,zero16,r32,hi);asm volatile("s_nop 15\n\ts_nop 7":"+v"(pA0),"+v"(pA1));CMASK(pA0,pA1,0);
  START(pA0,pA1);
  _Pragma("unroll") for(int r=0;r<16;++r)pA1[r]=__builtin_amdgcn_exp2f(pA1[r]);
  WAIT_BAR(0);
  DMA_K(3,0);DMA_V(1,SLOTB);
  ROT();
  kload8(kf,kp0+sl_cur);
  WAIT_BAR(3);
  s16x4 vlo[8],vhi[8]; u32x4 pw0,pw1,pw2,pw3;
  #define PKW(P,B) cvtpk_s(P[B],P[B+1])
  #define PAF(k) __builtin_bit_cast(bf16x8,pw##k)
  #define VFR(i) (bf16x8){vlo[i][0],vlo[i][1],vlo[i][2],vlo[i][3],vhi[i][0],vhi[i][1],vhi[i][2],vhi[i][3]}
  #define PIN(x) asm volatile("":"+v"(x))
  #define MX3(a,b,c) __builtin_fmaxf(__builtin_fmaxf((a),(b)),(c))
  #define GAPA(MF,A0,A1,A2,A3,W0,W1,PW) do{ MF; sacc+=A0; sacc+=A1; sacc+=A2; sacc+=A3; PIN(sacc); W0; W1; PIN(PW); SBAR(); }while(0)
  #define EX(v) __builtin_amdgcn_exp2f(v)
  #define GAPB(MF,X,B) do{ MF; X[B]=EX(X[B]); X[B+1]=EX(X[B+1]); X[B+2]=EX(X[B+2]); X[B+3]=EX(X[B+3]); PIN(X); SBAR(); }while(0)
  #define GAPB2(MF,X,B) do{ MF; X[B]=EX(X[B]); X[B+1]=EX(X[B+1]); PIN(X); SBAR(); }while(0)
  #define VRD(i) do{ vlo[i]=vtr(vp_+(((i)>>2)*4096+((i)&3)*1024)); vhi[i]=vtr(vp_+(((i)>>2)*4096+((i)&3)*1024+512)); }while(0)
  #define VRD2(i) do{ vlo[i]=vtr(vp_+8192+(((i)>>2)*4096+((i)&3)*1024)); vhi[i]=vtr(vp_+8192+(((i)>>2)*4096+((i)&3)*1024+512)); }while(0)
  #define KRD(G,j) do{ if(G){ kload2(kf,kp0+sl_next,j); SBAR(); } }while(0)
  #define STEP(C0,C1,P0,P1,t,GK,GV,GL) do{ SBAR(); \
    const lds_cptr vp_=vp0+2*sl_prev; \
    VRD(0); SBAR(); float sacc=(P0[0]+P0[1]); \
    GAPA(C0=__builtin_amdgcn_mfma_f32_32x32x16_bf16(kf[0],qr[0],zero16,0,0,0), P0[2],P0[3],P0[4],P0[5],     pw0[0]=PKW(P0,0), pw0[1]=PKW(P0,2), pw0); \
    VRD(4); SBAR(); GAPA(C1=__builtin_amdgcn_mfma_f32_32x32x16_bf16(kf[1],qr[0],zero16,0,0,0), P0[6],P0[7],P0[8],P0[9],     pw0[2]=PKW(P0,4), pw0[3]=PKW(P0,6), pw0); \
    VRD(1); SBAR(); GAPA(C0=__builtin_amdgcn_mfma_f32_32x32x16_bf16(kf[2],qr[1],C0,0,0,0),   P0[10],P0[11],P0[12],P0[13], pw1[0]=PKW(P0,8), pw1[1]=PKW(P0,10), pw1); \
    VRD(5); SBAR(); GAPA(C1=__builtin_amdgcn_mfma_f32_32x32x16_bf16(kf[3],qr[1],C1,0,0,0),   P0[14],P0[15],P1[0],P1[1],   pw1[2]=PKW(P0,12),pw1[3]=PKW(P0,14), pw1); \
    VRD(2); SBAR(); GAPA(C0=__builtin_amdgcn_mfma_f32_32x32x16_bf16(kf[4],qr[2],C0,0,0,0),   P1[2],P1[3],P1[4],P1[5],     pw2[0]=PKW(P1,0), pw2[1]=PKW(P1,2), pw2); \
    VRD(6); SBAR(); GAPA(C1=__builtin_amdgcn_mfma_f32_32x32x16_bf16(kf[5],qr[2],C1,0,0,0),   P1[6],P1[7],P1[8],P1[9],     pw2[2]=PKW(P1,4), pw2[3]=PKW(P1,6), pw2); \
    VRD(3); SBAR(); GAPA(C0=__builtin_amdgcn_mfma_f32_32x32x16_bf16(kf[6],qr[3],C0,0,0,0),   P1[10],P1[11],P1[12],P1[13], pw3[0]=PKW(P1,8), pw3[1]=PKW(P1,10), pw3); \
    VRD(7); SBAR(); GAPA(C1=__builtin_amdgcn_mfma_f32_32x32x16_bf16(kf[7],qr[3],C1,0,0,0),   P1[14],P1[15],0.f,0.f,       pw3[2]=PKW(P1,12),pw3[3]=PKW(P1,14), pw3); \
    l_reg+=sacc; \
    if(GK){DMA_K((t)+3,sl_cur);} if(GV){DMA_V((t)+1,sl_next);} \
    _Pragma("unroll") for(int r=0;r<16;++r){C0[r]-=mhat;C1[r]-=mhat;} \
    CMASK(C0,C1,t); \
    { float a=MX3(C0[0],C0[1],C1[0]),b=MX3(C0[2],C0[3],C1[1]); a=MX3(a,C1[2],C1[3]); \
      _Pragma("unroll") for(int r=4;r<16;r+=4){a=MX3(a,C0[r],C0[r+1]);b=MX3(b,C0[r+2],C0[r+3]);a=MX3(a,C1[r],C1[r+1]);b=MX3(b,C1[r+2],C1[r+3]);} \
      float rm=__builtin_fmaxf(a,b); { auto rr=__builtin_amdgcn_permlane32_swap(__float_as_uint(rm),__float_as_uint(rm),false,false); rm=__builtin_fmaxf(__uint_as_float(rr[0]),__uint_as_float(rr[1])); } \
      resc=false; \
      if(__builtin_expect(__any(rm>(float)THRL),0)){ const float dl=__builtin_fmaxf(rm,0.f); mhat+=dl; \
        _Pragma("unroll") for(int r=0;r<16;++r){C0[r]-=dl;C1[r]-=dl;} \
        const float f=__builtin_amdgcn_exp2f(-dl); l_reg*=f; if(hi==0)wsf[r32]=f; resc=true; } } \
    SBAR(); \
      \
      \
    GAPB2(o[0]=__builtin_amdgcn_mfma_f32_32x32x16_bf16(PAF(0),VFR(0),o[0],0,0,0), C0,0); \
    GAPB2(o[1]=__builtin_amdgcn_mfma_f32_32x32x16_bf16(PAF(0),VFR(4),o[1],0,0,0), C0,2); \
    KRD(GL,0); GAPB2(o[0]=__builtin_amdgcn_mfma_f32_32x32x16_bf16(PAF(1),VFR(1),o[0],0,0,0), C0,4); VRD2(0); SBAR(); \
    KRD(GL,1); GAPB2(o[1]=__builtin_amdgcn_mfma_f32_32x32x16_bf16(PAF(1),VFR(5),o[1],0,0,0), C0,6); VRD2(4); SBAR(); \
    KRD(GL,2); GAPB2(o[0]=__builtin_amdgcn_mfma_f32_32x32x16_bf16(PAF(2),VFR(2),o[0],0,0,0), C0,8); VRD2(1); SBAR(); \
    KRD(GL,3); GAPB2(o[1]=__builtin_amdgcn_mfma_f32_32x32x16_bf16(PAF(2),VFR(6),o[1],0,0,0), C0,10); VRD2(5); SBAR(); \
    GAPB2(o[0]=__builtin_amdgcn_mfma_f32_32x32x16_bf16(PAF(3),VFR(3),o[0],0,0,0), C0,12); VRD2(2); SBAR(); \
    GAPB2(o[1]=__builtin_amdgcn_mfma_f32_32x32x16_bf16(PAF(3),VFR(7),o[1],0,0,0), C0,14); VRD2(6); SBAR(); \
    GAPB2(o[2]=__builtin_amdgcn_mfma_f32_32x32x16_bf16(PAF(0),VFR(0),o[2],0,0,0), C1,0); VRD2(3); SBAR(); \
    GAPB2(o[3]=__builtin_amdgcn_mfma_f32_32x32x16_bf16(PAF(0),VFR(4),o[3],0,0,0), C1,2); VRD2(7); SBAR(); \
    GAPB2(o[2]=__builtin_amdgcn_mfma_f32_32x32x16_bf16(PAF(1),VFR(1),o[2],0,0,0), C1,4); \
    GAPB2(o[3]=__builtin_amdgcn_mfma_f32_32x32x16_bf16(PAF(1),VFR(5),o[3],0,0,0), C1,6); \
    GAPB2(o[2]=__builtin_amdgcn_mfma_f32_32x32x16_bf16(PAF(2),VFR(2),o[2],0,0,0), C1,8); \
    GAPB2(o[3]=__builtin_amdgcn_mfma_f32_32x32x16_bf16(PAF(2),VFR(6),o[3],0,0,0), C1,10); \
    GAPB2(o[2]=__builtin_amdgcn_mfma_f32_32x32x16_bf16(PAF(3),VFR(3),o[2],0,0,0), C1,12); \
    GAPB2(o[3]=__builtin_amdgcn_mfma_f32_32x32x16_bf16(PAF(3),VFR(7),o[3],0,0,0), C1,14); \
    }while(0)
  int t=1;
  #undef CMASK
  #define CMASK(P0,P1,t) do{}while(0)
  for(;t+5<NT;t+=2){
    STEP(pB0,pB1,pA0,pA1,t,true,true,true);     WAIT_BAR(3); RESC(); ROT();
    STEP(pA0,pA1,pB0,pB1,t+1,true,true,true);   WAIT_BAR(3); RESC(); ROT();
  }
  #undef CMASK
  #define CMASK(P0,P1,t) do{int jb_=(t)-(NT-4); if(jb_>=0)cmask(P0,P1,jb_,qrel,hi);}while(0)
  #define ENDW(tt) do{ if((tt)+3<NT){WAIT_BAR(3);} else if((tt)+2<NT){WAIT_BAR(2);} else {WAIT_BAR(0);} }while(0)
  for(;t+1<NT;t+=2){
    STEP(pB0,pB1,pA0,pA1,t,(t+3<NT),(t+1<NT),(t+1<NT));       ENDW(t);   RESC(); ROT();
    STEP(pA0,pA1,pB0,pB1,t+1,(t+4<NT),(t+2<NT),(t+2<NT));     ENDW(t+1); RESC(); ROT();
  }
  STEP(pB0,pB1,pA0,pA1,NT-1,false,false,false); RESC();
  { float sacc=pB0[0]+pB0[1]; _Pragma("unroll") for(int r=2;r<16;++r)sacc+=pB0[r]; _Pragma("unroll") for(int r=0;r<16;++r)sacc+=pB1[r]; l_reg+=sacc;
    pw0=(u32x4){PKW(pB0,0),PKW(pB0,2),PKW(pB0,4),PKW(pB0,6)};pw1=(u32x4){PKW(pB0,8),PKW(pB0,10),PKW(pB0,12),PKW(pB0,14)};pw2=(u32x4){PKW(pB1,0),PKW(pB1,2),PKW(pB1,4),PKW(pB1,6)};pw3=(u32x4){PKW(pB1,8),PKW(pB1,10),PKW(pB1,12),PKW(pB1,14)};
    SBAR(); pv(o,vb0+2*sl_cur,PAF(0),PAF(1),PAF(2),PAF(3)); pv(o+2,vb0+2*sl_cur+8192,PAF(0),PAF(1),PAF(2),PAF(3)); }
  #undef PKW
  #undef PAF
  #undef VFR
  #undef PIN
  #undef MX3
  #undef GAPA
  #undef GAPB
  #undef GAPB2
  #undef EX
  #undef VRD
  #undef VRD2
  #undef KRD
  #undef STEP
  #undef ENDW
  {auto rr=__builtin_amdgcn_permlane32_swap(__float_as_uint(l_reg),__float_as_uint(l_reg),false,false);l_reg=__uint_as_float(rr[0])+__uint_as_float(rr[1]);}
  if(hi==0)wsf[32+r32]=l_reg;asm volatile("s_waitcnt lgkmcnt(0)":::"memory");
  float rli[16];
  #pragma unroll
  for(int r=0;r<16;++r)rli[r]=__builtin_amdgcn_rcpf(wsf[32+crow(r,hi)]);
  bf16*Ow=O+(rowbase+q0+wid*QBLK)*PO;
  { bf16*stg=(bf16*)(shm+LDS_OST)+wid*2048;
    #pragma unroll
    for(int hf=0;hf<2;++hf){
      #pragma unroll
      for(int r=0;r<16;++r){const int orow=crow(r,hi);
        #pragma unroll
        for(int d0=0;d0<2;++d0)stg[orow*64+d0*32+r32]=__float2bfloat16(o[2*hf+d0][r]*rli[r]);}
      asm volatile("s_waitcnt lgkmcnt(0)":::"memory");
      #pragma unroll
      for(int i=0;i<4;++i){const int row=i*8+(lane>>3),ch=lane&7; const u32x4 v=*(const u32x4*)(stg+row*64+ch*8); ATTN_STORE16(Ow+(long)row*PO+hf*64+ch*8,v);}
      asm volatile("s_waitcnt lgkmcnt(0)":::"memory"); } }
  asm volatile("s_waitcnt lgkmcnt(0)\n\ts_barrier":::"memory");
  #undef DMA_K
  #undef DMA_V
  #undef CMASK
  #undef START
  #undef RESC
  #undef ROT
}
constexpr int ATTN_LDS_BYTES=LDS_BYTES;
#undef SBAR
#undef WAIT_BAR
}
constexpr int NWAVES = 8;
constexpr int BATCH = 2, SEQ = 16384, DM = 2048, M = BATCH * SEQ, NMEM = 256;
constexpr int IN_W = 6160, PJ = 6144;
constexpr int C_GQ = 0, C_GK = 512, C_GV = 1024, C_GG = 2048, C_DQ = 3072, C_DK = 3584, C_DV = 4096, C_DG = 4608, C_MQ = 5120, C_MG = 5632;
constexpr float LN_EPS = 1e-5f, GLA_EPS = 1e-6f, DIFF_EPS = 1e-5f;
constexpr float ALPHA = 1.189207115002721f;
constexpr float LAM_INIT = 0.2f;
constexpr size_t MiB = 1u << 20;
constexpr size_t WS_CTL = 0, CTL_ZERO_BYTES = 32768;
constexpr size_t WS_WIN_T = 2 * MiB, WS_WOUT_T = 26 * MiB, WS_WMKV_T = 34 * MiB, WS_MEMB = 38 * MiB, WS_MK = 40 * MiB, WS_MVT = 41 * MiB;
constexpr size_t WS_CS = 42 * MiB, WS_GLR = 44 * MiB, WS_XB = 48 * MiB, WS_PROJ = 176 * MiB, WS_OBUF = 560 * MiB, WS_QF = 624 * MiB, WS_KF = 656 * MiB, WS_VF = 688 * MiB, WS_AL = 752 * MiB, WS_OI = 754 * MiB, WS_OX = 818 * MiB, WS_END = 882 * MiB;
constexpr size_t WS_MIX = WS_XB;
constexpr size_t WS_OUTB = WS_PROJ;
constexpr int RING_BYTES = 131072, CHAIN_RING_BYTES = 3 * 49 * 1024, MISC_OFF = CHAIN_RING_BYTES + 1024, WSF_OFF = CHAIN_RING_BYTES + 2048, LDS_BYTES = CHAIN_RING_BYTES + 5120;

#define GAS __attribute__((address_space(1)))
#define LAS __attribute__((address_space(3)))
#define DI __device__ __forceinline__
typedef unsigned short bf16;
typedef unsigned v4u __attribute__((ext_vector_type(4)));
typedef unsigned v2u __attribute__((ext_vector_type(2)));
typedef float f32x4 __attribute__((ext_vector_type(4)));
typedef float f32x16 __attribute__((ext_vector_type(16)));
typedef short bf16x8 __attribute__((ext_vector_type(8)));
typedef short s16x4 __attribute__((ext_vector_type(4)));
typedef float f32x2_t __attribute__((ext_vector_type(2))); typedef __bf16 bf16x2_t __attribute__((ext_vector_type(2)));
DI unsigned cvtpk(float lo, float hi) { f32x2_t v = {lo, hi}; bf16x2_t b = __builtin_convertvector(v, bf16x2_t); return __builtin_bit_cast(unsigned, b); }
DI float bf2f(unsigned short u) { return __uint_as_float((unsigned)u << 16); }
DI float bflo(unsigned u) { return __uint_as_float(u << 16); }
DI float bfhi(unsigned u) { return __uint_as_float(u & 0xffff0000u); }
DI int crow(int r, int hi) { return (r & 3) + 8 * (r >> 2) + 4 * hi; }
DI float wave_sum(float v) {
#pragma unroll
    for (int o = 1; o < 64; o <<= 1) v += __shfl_xor(v, o);
    return v;
}
DI int fresh_tid(int wv) { int t = wv * 64 + (int)__builtin_amdgcn_mbcnt_hi(~0u, __builtin_amdgcn_mbcnt_lo(~0u, 0u)); asm volatile("" : "+v"(t)); return t; }
DI float silu(float g) { return g * __builtin_amdgcn_rcpf(1.f + __expf(-g)); }
#define MFMA32(a, b, c) __builtin_amdgcn_mfma_f32_32x32x16_bf16((a), (b), (c), 0, 0, 0)
DI bf16x8 pack_step(const f32x16& x, int s) {
    v4u p;
    p.x = cvtpk(x[8 * s + 0], x[8 * s + 1]); p.y = cvtpk(x[8 * s + 2], x[8 * s + 3]); p.z = cvtpk(x[8 * s + 4], x[8 * s + 5]); p.w = cvtpk(x[8 * s + 6], x[8 * s + 7]);
    return __builtin_bit_cast(bf16x8, p);
}

struct Args {
    const float* x; const float* mem; const int* pos; const float* w_in; const float* w_gk_up; const float* b_gk_up; const float* gla_g;
    const float* lq1; const float* lk1; const float* lq2; const float* lk2; const float* diff_g; const float* w_mkv; const float* w_out; const float* ln_g; const float* ln_b;
    float* out; unsigned char* ws;
    float inv_freq[8];
    int ph_lo, ph_hi, coop, pad;
};

DI void p0_transpose_item(const float* W, int ldw, int K, int ncols, bf16* WT, int row_off, LAS float* scr, int item, int lane) {
    const int nblk = ncols / 32, kb = item / nblk, nb = item % nblk, k0 = 64 * kb, n0 = 32 * nb;
#pragma unroll 8
    for (int i = 0; i < 32; ++i) { const int kk = 2 * i + (lane >> 5); scr[kk * 33 + (lane & 31)] = W[(size_t)(k0 + kk) * ldw + n0 + (lane & 31)]; }
    asm volatile("s_waitcnt lgkmcnt(0)" ::: "memory");
    const int c = lane & 7;
#pragma unroll
    for (int j = 0; j < 4; ++j) { const int n = (lane >> 3) + 8 * j; const LAS float* s = scr + (8 * c) * 33 + n;
        v4u o; o.x = cvtpk(s[0 * 33], s[1 * 33]); o.y = cvtpk(s[2 * 33], s[3 * 33]); o.z = cvtpk(s[4 * 33], s[5 * 33]); o.w = cvtpk(s[6 * 33], s[7 * 33]);
        *(v4u*)(WT + (size_t)(row_off + n0 + n) * K + k0 + 8 * c) = o; }
    asm volatile("s_waitcnt lgkmcnt(0)" ::: "memory");
}
DI void p0_prologue(const Args& a, LAS unsigned char* lds, int bx, int G, int wv) {
    const int tid = fresh_tid(wv), lane = tid & 63, wave = __builtin_amdgcn_readfirstlane(tid >> 6);
    unsigned char* ws = a.ws;
    LAS float* scr = (LAS float*)(lds + wave * 16384);
    const int gw = bx * NWAVES + wave, NGW = G * NWAVES;
    constexpr int I_IN = (DM / 64) * (3072 / 32), I_OUT = (DM / 64) * (DM / 32), I_MKV = (DM / 64) * (1024 / 32);
    constexpr int NITEMS = 2 * I_IN + I_OUT + I_MKV;
    for (int it = gw; it < NITEMS; it += NGW) {
        int r = it;
        if (r < I_IN) { p0_transpose_item(a.w_in, IN_W, DM, 3072, (bf16*)(ws + WS_WIN_T), 0, scr, r, lane); continue; } r -= I_IN;
        if (r < I_IN) { p0_transpose_item(a.w_in + 3088, IN_W, DM, 3072, (bf16*)(ws + WS_WIN_T), 3072, scr, r, lane); continue; } r -= I_IN;
        if (r < I_OUT) { p0_transpose_item(a.w_out, DM, DM, DM, (bf16*)(ws + WS_WOUT_T), 0, scr, r, lane); continue; } r -= I_OUT;
        p0_transpose_item(a.w_mkv, 1024, DM, 1024, (bf16*)(ws + WS_WMKV_T), 0, scr, r, lane);
    }
    __syncthreads();
    LAS float* wT = (LAS float*)lds;
#pragma unroll 1
    for (int i0 = 0; i0 < 64; i0 += 16) {
        float t16[16];
#pragma unroll
        for (int i = 0; i < 16; ++i) { const int idx = tid + 512 * (i0 + i); t16[i] = a.w_in[(size_t)(idx >> 4) * IN_W + 3072 + (idx & 15)]; }
#pragma unroll
        for (int i = 0; i < 16; ++i) { const int idx = tid + 512 * (i0 + i); wT[(idx & 15) * 2048 + (idx >> 4)] = t16[i]; }
    }
    __syncthreads();
    float* glr = (float*)(ws + WS_GLR); bf16* xb = (bf16*)(ws + WS_XB);
    {
        f32x4 vn[8];
        if (gw < M) { const f32x4* xr = (const f32x4*)(a.x + (size_t)gw * DM) + lane;
#pragma unroll
            for (int j = 0; j < 8; ++j) vn[j] = __builtin_nontemporal_load(xr + 64 * j); }
        for (int row = gw; row < M; row += NGW) {
            f32x4 v[8];
#pragma unroll
            for (int j = 0; j < 8; ++j) v[j] = vn[j];
            if (row + NGW < M) { const f32x4* xr = (const f32x4*)(a.x + (size_t)(row + NGW) * DM) + lane;
#pragma unroll
                for (int j = 0; j < 8; ++j) vn[j] = __builtin_nontemporal_load(xr + 64 * j); }
            v2u* o8 = (v2u*)(xb + (size_t)row * DM) + lane;
#pragma unroll
            for (int j = 0; j < 8; ++j) { v2u o; o.x = cvtpk(v[j].x, v[j].y); o.y = cvtpk(v[j].z, v[j].w); o8[64 * j] = o; }
            float res = 0.f;
#pragma unroll 1
            for (int rg = 0; rg < 4; ++rg) {
                float ac0 = 0.f, ac1 = 0.f, ac2 = 0.f, ac3 = 0.f;
                const LAS float* wp = wT + rg * 4 * 2048 + 4 * lane;
#pragma unroll
                for (int j = 0; j < 8; ++j) {
                    const f32x4 w0 = *(const LAS f32x4*)(wp + 256 * j), w1 = *(const LAS f32x4*)(wp + 2048 + 256 * j), w2 = *(const LAS f32x4*)(wp + 4096 + 256 * j), w3 = *(const LAS f32x4*)(wp + 6144 + 256 * j);
                    ac0 += v[j].x * w0.x + v[j].y * w0.y + v[j].z * w0.z + v[j].w * w0.w;
                    ac1 += v[j].x * w1.x + v[j].y * w1.y + v[j].z * w1.z + v[j].w * w1.w;
                    ac2 += v[j].x * w2.x + v[j].y * w2.y + v[j].z * w2.z + v[j].w * w2.w;
                    ac3 += v[j].x * w3.x + v[j].y * w3.y + v[j].z * w3.z + v[j].w * w3.w;
                }
                const bool b0 = (lane & 1) != 0, b1 = (lane & 2) != 0;
                float a01 = (b0 ? ac1 : ac0) + __shfl_xor(b0 ? ac0 : ac1, 1);
                float a23 = (b0 ? ac3 : ac2) + __shfl_xor(b0 ? ac2 : ac3, 1);
                float bq = (b1 ? a23 : a01) + __shfl_xor(b1 ? a01 : a23, 2);
                bq += __shfl_xor(bq, 4); bq += __shfl_xor(bq, 8); bq += __shfl_xor(bq, 16); bq += __shfl_xor(bq, 32);
                res = ((lane >> 2) == rg) ? bq : res;
            }
            if (lane < 16) glr[(size_t)row * 16 + lane] = res;
        }
    }
    const int gt = bx * 512 + tid, NT = G * 512;
    float* cs = (float*)(ws + WS_CS);
    for (int idx = gt; idx < M * 8; idx += NT) {
        const int tok = idx >> 3, i = idx & 7;
        float invf = a.inv_freq[0];
#pragma unroll
        for (int q = 1; q < 8; ++q) invf = (i == q) ? a.inv_freq[q] : invf;
        const float ang = (float)a.pos[tok] * invf;
        double td = (double)ang * 0.15915494309189535; td -= rint(td);
        const float tf = (float)td;
        cs[(size_t)tok * 16 + i] = __builtin_amdgcn_cosf(tf); cs[(size_t)tok * 16 + 8 + i] = __builtin_amdgcn_sinf(tf);
    }
    bf16* memb = (bf16*)(ws + WS_MEMB);
    for (int idx = gt; idx < BATCH * NMEM * DM / 4; idx += NT) { const f32x4 v = ((const f32x4*)a.mem)[idx]; v2u o; o.x = cvtpk(v.x, v.y); o.y = cvtpk(v.z, v.w); ((v2u*)memb)[idx] = o; }
    __syncthreads();
}

constexpr int G_QS = 0, G_KS = 17408, G_KDT = 34816, G_VT = 53248, G_PS = 90112, G_GL = 99328, G_TOT = 103424, G_AL = 105472;
constexpr int QP = 272, KP = 144;
DI float log_sigmoid(float x) { return fminf(x, 0.f) - __logf(1.f + __expf(-fabsf(x))); }
DI void gla_pre(int u, const bf16* proj, const float* glr, const float* w_up, const float* b_up, bf16* QF, bf16* KF, bf16* VF, float* ALg, bf16* OI, LAS unsigned char* lds, int wv) {
    const int tid = fresh_tid(wv), lane = tid & 63, r32 = lane & 31, hi = lane >> 5, w = __builtin_amdgcn_readfirstlane(tid >> 6);
    const int b = u >> 10, h = (u >> 8) & 3, c = u & 255;
    const int dk = tid & 127, qt = tid >> 7;
    const int dvl = tid & 255, th = tid >> 8;
    LAS float* GL = (LAS float*)(lds + G_GL); LAS float* TOT = (LAS float*)(lds + G_TOT); LAS float* AL = (LAS float*)(lds + G_AL);
    const size_t tok0 = (size_t)b * SEQ + (size_t)c * 64;
    if (tid < 256) ((LAS f32x4*)GL)[tid] = ((const f32x4*)(glr + tok0 * 16))[tid];
    float wu[16];
#pragma unroll
    for (int r = 0; r < 16; ++r) wu[r] = w_up[r * 512 + h * 128 + dk];
    const float bu = b_up[h * 128 + dk];
    unsigned short qv[16], kv[16];
#pragma unroll
    for (int i = 0; i < 16; ++i) { const bf16* p = proj + (tok0 + 16 * qt + i) * PJ + h * 128 + dk; qv[i] = p[C_GQ]; kv[i] = p[C_GK]; }
    unsigned short vv[32];
#pragma unroll
    for (int i = 0; i < 32; ++i) vv[i] = proj[(tok0 + 32 * th + i) * PJ + C_GV + h * 256 + dvl];
    __syncthreads();
    float cb[16]; float run = 0.f;
#pragma unroll
    for (int i = 0; i < 16; ++i) {
        const LAS float* g = GL + (16 * qt + i) * 16; float lg = bu;
#pragma unroll
        for (int r = 0; r < 16; ++r) lg += g[r] * wu[r];
        run += log_sigmoid(lg) * (1.f / 16.f); cb[i] = run;
    }
    TOT[qt * 128 + dk] = run;
    {
        LAS unsigned char* vp = lds + G_VT + dvl * KP + th * 64;
#pragma unroll
        for (int q = 0; q < 4; ++q) { v4u o; o.x = vv[8 * q] | ((unsigned)vv[8 * q + 1] << 16); o.y = vv[8 * q + 2] | ((unsigned)vv[8 * q + 3] << 16);
            o.z = vv[8 * q + 4] | ((unsigned)vv[8 * q + 5] << 16); o.w = vv[8 * q + 6] | ((unsigned)vv[8 * q + 7] << 16); *(LAS v4u*)(vp + q * 16) = o; }
    }
    __syncthreads();
    float off = 0.f, total = 0.f;
#pragma unroll
    for (int q = 0; q < 4; ++q) { const float t = TOT[q * 128 + dk]; total += t; off += (q < qt) ? t : 0.f; }
    {
        const float etot = __expf(total);
        unsigned kdp[8];
#pragma unroll
        for (int i = 0; i < 16; i += 2) {
            const float e0 = __expf(cb[i] + off), e1 = __expf(cb[i + 1] + off);
            const float r0 = __builtin_amdgcn_rcpf(e0), r1 = __builtin_amdgcn_rcpf(e1);
            const float k0 = bf2f(kv[i]) * r0, k1 = bf2f(kv[i + 1]) * r1;
            const unsigned qq = cvtpk(bf2f(qv[i]) * e0, bf2f(qv[i + 1]) * e1), kk = cvtpk(k0, k1);
            kdp[i >> 1] = cvtpk(k0 * etot, k1 * etot);
            const int t0 = 16 * qt + i;
            *(LAS unsigned short*)(lds + G_QS + t0 * QP + dk * 2) = (unsigned short)(qq & 0xffffu);
            *(LAS unsigned short*)(lds + G_QS + (t0 + 1) * QP + dk * 2) = (unsigned short)(qq >> 16);
            *(LAS unsigned short*)(lds + G_KS + t0 * QP + dk * 2) = (unsigned short)(kk & 0xffffu);
            *(LAS unsigned short*)(lds + G_KS + (t0 + 1) * QP + dk * 2) = (unsigned short)(kk >> 16);
        }
        LAS unsigned char* kp = lds + G_KDT + dk * KP + qt * 32;
        *(LAS v4u*)(kp) = (v4u){kdp[0], kdp[1], kdp[2], kdp[3]}; *(LAS v4u*)(kp + 16) = (v4u){kdp[4], kdp[5], kdp[6], kdp[7]};
        if (qt == 0) ALg[(size_t)u * 256 + dk] = etot;
    }
    __syncthreads();
    if (w < 3) {
        const int it = (w == 0) ? 0 : 1, jt = (w == 2) ? 1 : 0;
        f32x16 sT;
#pragma unroll
        for (int r = 0; r < 16; ++r) sT[r] = 0.f;
#pragma unroll
        for (int s = 0; s < 8; ++s) {
            const bf16x8 A = *(const LAS bf16x8*)(lds + G_KS + (32 * jt + r32) * QP + (16 * s + 8 * hi) * 2);
            const bf16x8 B = *(const LAS bf16x8*)(lds + G_QS + (32 * it + r32) * QP + (16 * s + 8 * hi) * 2);
            sT = MFMA32(A, B, sT);
        }
        const int ii = 32 * it + r32;
#pragma unroll
        for (int g = 0; g < 4; ++g) {
            const int j0 = 32 * jt + 8 * g + 4 * hi;
            const float p0 = (j0 + 0 <= ii) ? sT[4 * g + 0] : 0.f, p1 = (j0 + 1 <= ii) ? sT[4 * g + 1] : 0.f, p2 = (j0 + 2 <= ii) ? sT[4 * g + 2] : 0.f, p3 = (j0 + 3 <= ii) ? sT[4 * g + 3] : 0.f;
            *(LAS v2u*)(lds + G_PS + ii * KP + j0 * 2) = (v2u){cvtpk(p0, p1), cvtpk(p2, p3)};
        }
    } else if (w == 3) {
#pragma unroll
        for (int g = 0; g < 4; ++g) *(LAS v2u*)(lds + G_PS + r32 * KP + (32 + 8 * g + 4 * hi) * 2) = (v2u){0u, 0u};
    }
#pragma unroll
    for (int e = 0; e < 2; ++e) {
        const int f = 2 * w + e;
        { const int it = f >> 3, t = (f >> 1) & 3, s = f & 1;
          const LAS unsigned char* qp = lds + G_QS + (32 * it + r32) * QP + (32 * t + 16 * s + 4 * hi) * 2;
          const v2u lo = *(const LAS v2u*)(qp), hh = *(const LAS v2u*)(qp + 16);
          *(v4u*)(QF + (((size_t)u * 16 + f) * 64 + lane) * 8) = (v4u){lo.x, lo.y, hh.x, hh.y}; }
        { const int t = f >> 2, ks = f & 3;
          const v4u kf = *(const LAS v4u*)(lds + G_KDT + (32 * t + r32) * KP + (16 * ks + 8 * hi) * 2);
          *(v4u*)(KF + (((size_t)u * 16 + f) * 64 + lane) * 8) = kf; }
    }
    __syncthreads();
    {
        f32x16 o[2];
#pragma unroll
        for (int r = 0; r < 16; ++r) { o[0][r] = 0.f; o[1][r] = 0.f; }
        bf16x8 Bv[4];
#pragma unroll
        for (int ks = 0; ks < 4; ++ks) { Bv[ks] = *(const LAS bf16x8*)(lds + G_VT + (32 * w + r32) * KP + (16 * ks + 8 * hi) * 2);
            *(bf16x8*)(VF + (((size_t)u * 32 + w * 4 + ks) * 64 + lane) * 8) = Bv[ks]; }
#pragma unroll
        for (int it = 0; it < 2; ++it)
#pragma unroll
            for (int ks = 0; ks < 4; ++ks) { const bf16x8 A = *(const LAS bf16x8*)(lds + G_PS + (32 * it + r32) * KP + (16 * ks + 8 * hi) * 2); o[it] = MFMA32(A, Bv[ks], o[it]); }
#pragma unroll
        for (int it = 0; it < 2; ++it)
#pragma unroll
            for (int r = 0; r < 16; r += 2) {
                const unsigned pk = cvtpk(o[it][r], o[it][r + 1]);
                bf16* op = OI + (tok0 + 32 * it + crow(r, hi)) * 1024 + h * 256 + 32 * w + r32;
                op[0] = (bf16)(pk & 0xffffu); op[1024] = (bf16)(pk >> 16);
            }
    }
    __syncthreads();
}
constexpr int CH_SLOT = 49 * 1024;
DI void gla_chain_wg(int b, int h, int dvh, const bf16* QF, const bf16* KF, const bf16* VF, const float* ALg, bf16* OX, LAS unsigned char* lds, int wv) {
    const int tid = fresh_tid(wv), lane = tid & 63, r32 = lane & 31, hi = lane >> 5, w = wv;
    const unsigned lds0 = (unsigned)(size_t)lds;
    constexpr int NC = SEQ / 64;
    const bool active = w < 4;
    const int dvb = dvh * 4 + (w & 3);
    f32x16 S[4];
#pragma unroll
    for (int t = 0; t < 4; ++t)
#pragma unroll
        for (int r = 0; r < 16; ++r) S[t][r] = 0.f;
    f32x16 o[2];
#pragma unroll
    for (int r = 0; r < 16; ++r) { o[0][r] = 0.f; o[1][r] = 0.f; }
    const size_t u0 = (size_t)(b * 4 + h) * 256;
#define CH_DMA(cc, slot) do { const size_t u_ = u0 + (cc); const unsigned d_ = lds0 + (slot) * CH_SLOT; \
        attn_body::glds16nt(QF + (u_ * 16 + w) * 512 + lane * 8,                  (unsigned)__builtin_amdgcn_readfirstlane(d_ + w * 1024)); \
        attn_body::glds16nt(QF + (u_ * 16 + w + 8) * 512 + lane * 8,              (unsigned)__builtin_amdgcn_readfirstlane(d_ + (w + 8) * 1024)); \
        attn_body::glds16nt(KF + (u_ * 16 + w) * 512 + lane * 8,                  (unsigned)__builtin_amdgcn_readfirstlane(d_ + (16 + w) * 1024)); \
        attn_body::glds16nt(KF + (u_ * 16 + w + 8) * 512 + lane * 8,              (unsigned)__builtin_amdgcn_readfirstlane(d_ + (24 + w) * 1024)); \
        attn_body::glds16nt(VF + (u_ * 32 + dvh * 16 + w) * 512 + lane * 8,       (unsigned)__builtin_amdgcn_readfirstlane(d_ + (32 + w) * 1024)); \
        attn_body::glds16nt(VF + (u_ * 32 + dvh * 16 + w + 8) * 512 + lane * 8,   (unsigned)__builtin_amdgcn_readfirstlane(d_ + (40 + w) * 1024)); \
        attn_body::glds16nt(ALg + u_ * 256 + lane * 4,                            (unsigned)__builtin_amdgcn_readfirstlane(d_ + 48 * 1024)); } while (0)
    CH_DMA(0, 0);
    CH_DMA(1, 1);
    int slot = 0;
#pragma unroll 1
    for (int c = 0; c < NC; ++c) {
        if (c < 2 || c >= NC - 2) asm volatile("s_waitcnt vmcnt(0) lgkmcnt(0)\n\ts_barrier" ::: "memory");
        else if (active) asm volatile("s_waitcnt vmcnt(39) lgkmcnt(0)\n\ts_barrier" ::: "memory");
        else asm volatile("s_waitcnt vmcnt(7) lgkmcnt(0)\n\ts_barrier" ::: "memory");
        if (active && c > 0) {
            const size_t tokp = (size_t)b * SEQ + (size_t)(c - 1) * 64;
#pragma unroll
            for (int it = 0; it < 2; ++it)
#pragma unroll
                for (int r = 0; r < 16; r += 2) {
                    const unsigned pk = cvtpk(o[it][r], o[it][r + 1]);
                    bf16* op = OX + (tokp + 32 * it + crow(r, hi)) * 1024 + h * 256 + 32 * dvb + r32;
                    op[0] = (bf16)(pk & 0xffffu); op[1024] = (bf16)(pk >> 16);
                }
        }
        const int slot2 = (slot == 0) ? 2 : slot - 1;
        if (c + 2 < NC) CH_DMA(c + 2, slot2);
        if (active) {
            const LAS unsigned char* sl = lds + slot * CH_SLOT;
#pragma unroll
            for (int r = 0; r < 16; ++r) { o[0][r] = 0.f; o[1][r] = 0.f; }
#pragma unroll
            for (int t = 0; t < 4; ++t)
#pragma unroll
                for (int s = 0; s < 2; ++s) {
                    const bf16x8 Bs = pack_step(S[t], s);
                    const bf16x8 q0 = *(const LAS bf16x8*)(sl + (t * 2 + s) * 1024 + lane * 16), q1 = *(const LAS bf16x8*)(sl + (8 + t * 2 + s) * 1024 + lane * 16);
                    o[0] = MFMA32(q0, Bs, o[0]);
                    o[1] = MFMA32(q1, Bs, o[1]);
                }
            bf16x8 vf[4];
#pragma unroll
            for (int ks = 0; ks < 4; ++ks) vf[ks] = *(const LAS bf16x8*)(sl + (32 + (w & 3) * 4 + ks) * 1024 + lane * 16);
#pragma unroll
            for (int t = 0; t < 4; ++t) {
#pragma unroll
                for (int g = 0; g < 4; ++g) { const f32x4 al = *(const LAS f32x4*)(sl + 48 * 1024 + (32 * t + 8 * g + 4 * hi) * 4);
                    S[t][4 * g + 0] *= al.x; S[t][4 * g + 1] *= al.y; S[t][4 * g + 2] *= al.z; S[t][4 * g + 3] *= al.w; }
#pragma unroll
                for (int ks = 0; ks < 4; ++ks) { const bf16x8 kf = *(const LAS bf16x8*)(sl + (16 + t * 4 + ks) * 1024 + lane * 16); S[t] = MFMA32(kf, vf[ks], S[t]); }
            }
        }
        slot = (slot == 2) ? 0 : slot + 1;
    }
    if (active) {
        const size_t tokp = (size_t)b * SEQ + (size_t)(NC - 1) * 64;
#pragma unroll
        for (int it = 0; it < 2; ++it)
#pragma unroll
            for (int r = 0; r < 16; r += 2) {
                const unsigned pk = cvtpk(o[it][r], o[it][r + 1]);
                bf16* op = OX + (tokp + 32 * it + crow(r, hi)) * 1024 + h * 256 + 32 * dvb + r32;
                op[0] = (bf16)(pk & 0xffffu); op[1024] = (bf16)(pk >> 16);
            }
    }
#undef CH_DMA
    asm volatile("s_waitcnt vmcnt(0) lgkmcnt(0)\n\ts_barrier" ::: "memory");
}

DI void mem_unit(int b, int h, int qb, const bf16* proj, const bf16* mk, const bf16* mvT, bf16* mix, LAS unsigned char* lds, int wv) {
    const int tid = fresh_tid(wv), lane = tid & 63, r32 = lane & 31, hi = lane >> 5, w = __builtin_amdgcn_readfirstlane(tid >> 6);
    LAS unsigned char* Kms = lds; LAS unsigned char* VmT = lds + 65536;
#pragma unroll
    for (int i = 0; i < 8; ++i) { const int idx = tid + 512 * i, m = idx >> 4, c = idx & 15;
        const v4u v = *(const v4u*)(mk + (size_t)(b * 256 + m) * 512 + h * 128 + c * 8); *(LAS v4u*)(Kms + m * 256 + ((c ^ (m & 15)) * 16)) = v; }
#pragma unroll
    for (int i = 0; i < 8; ++i) { const int idx = tid + 512 * i, d = idx >> 5, c = idx & 31;
        const v4u v = *(const v4u*)(mvT + (size_t)((b * 4 + h) * 128 + d) * 256 + c * 8); *(LAS v4u*)(VmT + d * 512 + ((c ^ (d & 15)) * 16)) = v; }
    const size_t row0 = (size_t)b * SEQ + (size_t)qb * 256 + 32 * w;
    bf16x8 qf[8];
#pragma unroll
    for (int s = 0; s < 8; ++s) qf[s] = *(const bf16x8*)(proj + (row0 + r32) * PJ + C_MQ + h * 128 + 16 * s + 8 * hi);
    __syncthreads();
    const int sw = r32 & 15;
    float mx = -INFINITY;
#pragma unroll 1
    for (int kt = 0; kt < 8; ++kt) {
        f32x16 sT;
#pragma unroll
        for (int r = 0; r < 16; ++r) sT[r] = 0.f;
#pragma unroll
        for (int s = 0; s < 8; ++s) { const bf16x8 A = *(const LAS bf16x8*)(Kms + (32 * kt + r32) * 256 + (((2 * s + hi) ^ sw) * 16)); sT = MFMA32(A, qf[s], sT); }
#pragma unroll
        for (int r = 0; r < 16; ++r) mx = fmaxf(mx, sT[r]);
    }
    mx = fmaxf(mx, __shfl_xor(mx, 32));
    float l = 0.f;
    f32x16 o[4];
#pragma unroll
    for (int dt = 0; dt < 4; ++dt)
#pragma unroll
        for (int r = 0; r < 16; ++r) o[dt][r] = 0.f;
#pragma unroll 1
    for (int kt = 0; kt < 8; ++kt) {
        f32x16 sT;
#pragma unroll
        for (int r = 0; r < 16; ++r) sT[r] = 0.f;
#pragma unroll
        for (int s = 0; s < 8; ++s) { const bf16x8 A = *(const LAS bf16x8*)(Kms + (32 * kt + r32) * 256 + (((2 * s + hi) ^ sw) * 16)); sT = MFMA32(A, qf[s], sT); }
#pragma unroll
        for (int r = 0; r < 16; ++r) { sT[r] = __builtin_amdgcn_exp2f(sT[r] - mx); l += sT[r]; }
#pragma unroll
        for (int s2 = 0; s2 < 2; ++s2) {
            const bf16x8 Pa = pack_step(sT, s2);
            const int c0 = 4 * kt + 2 * s2;
#pragma unroll
            for (int dt = 0; dt < 4; ++dt) {
                const LAS unsigned char* vr = VmT + (32 * dt + r32) * 512 + 8 * hi;
                const s16x4 lo = *(const LAS s16x4*)(vr + ((c0 ^ sw) * 16)), hh = *(const LAS s16x4*)(vr + (((c0 + 1) ^ sw) * 16));
                const bf16x8 Bv = __builtin_shufflevector(lo, hh, 0, 1, 2, 3, 4, 5, 6, 7);
                o[dt] = MFMA32(Pa, Bv, o[dt]);
            }
        }
    }
    l += __shfl_xor(l, 32);
    volatile LAS float* wsf = (volatile LAS float*)(lds + WSF_OFF) + w * 64;
    if (hi == 0) wsf[r32] = 1.f / l;
    asm volatile("s_waitcnt lgkmcnt(0)" ::: "memory"); __builtin_amdgcn_wave_barrier();
    float rl[16];
#pragma unroll
    for (int r = 0; r < 16; ++r) rl[r] = wsf[crow(r, hi)];
#pragma unroll
    for (int dt = 0; dt < 4; ++dt)
#pragma unroll
        for (int r = 0; r < 16; ++r) {
            const size_t row = row0 + crow(r, hi); const int col = h * 128 + 32 * dt + r32;
            const float g = bf2f(proj[row * PJ + C_MG + col]);
            const unsigned pk = cvtpk(o[dt][r] * rl[r] * silu(g), 0.f);
            mix[row * DM + 1536 + col] = (bf16)(pk & 0xffffu);
        }
    __syncthreads();
}

DI void combine_pass(const Args& a, int bx, int G, int wv) {
    const int tid = fresh_tid(wv), lane = tid & 63, gw = bx * NWAVES + __builtin_amdgcn_readfirstlane(tid >> 6), NGW = G * NWAVES;
    const bf16* obuf = (const bf16*)(a.ws + WS_OBUF); const bf16* proj = (const bf16*)(a.ws + WS_PROJ); bf16* mix = (bf16*)(a.ws + WS_MIX);
    const float s1 = wave_sum(a.lq1[lane] * a.lk1[lane]), s2 = wave_sum(a.lq2[lane] * a.lk2[lane]);
    const float lam = expf(s1) - expf(s2) + LAM_INIT;
    const bf16* OI = (const bf16*)(a.ws + WS_OI); const bf16* OX = (const bf16*)(a.ws + WS_OX);
    const int l32 = lane & 31, hh = lane >> 5, l16 = lane & 15, hd = lane >> 4;
    const f32x4 gg0 = *(const f32x4*)(a.gla_g + 8 * l32), gg1 = *(const f32x4*)(a.gla_g + 8 * l32 + 4);
    const f32x4 dg0 = *(const f32x4*)(a.diff_g + 8 * l16) * (1.f - LAM_INIT), dg1 = *(const f32x4*)(a.diff_g + 8 * l16 + 4) * (1.f - LAM_INIT);
    for (int row = gw; row < M; row += NGW) {
#pragma unroll
        for (int p = 0; p < 2; ++p) {
            const int h = 2 * p + hh;
            const v4u oi = __builtin_nontemporal_load((const v4u*)(OI + (size_t)row * 1024 + h * 256 + 8 * l32)), ox = __builtin_nontemporal_load((const v4u*)(OX + (size_t)row * 1024 + h * 256 + 8 * l32));
            const v4u ug = __builtin_nontemporal_load((const v4u*)(proj + (size_t)row * PJ + C_GG + h * 256 + 8 * l32));
            float o[8];
            o[0] = bflo(oi.x) + bflo(ox.x); o[1] = bfhi(oi.x) + bfhi(ox.x); o[2] = bflo(oi.y) + bflo(ox.y); o[3] = bfhi(oi.y) + bfhi(ox.y);
            o[4] = bflo(oi.z) + bflo(ox.z); o[5] = bfhi(oi.z) + bfhi(ox.z); o[6] = bflo(oi.w) + bflo(ox.w); o[7] = bfhi(oi.w) + bfhi(ox.w);
            float ssq = (o[0] * o[0] + o[1] * o[1]) + (o[2] * o[2] + o[3] * o[3]) + (o[4] * o[4] + o[5] * o[5]) + (o[6] * o[6] + o[7] * o[7]);
            ssq += __shfl_xor(ssq, 1); ssq += __shfl_xor(ssq, 2); ssq += __shfl_xor(ssq, 4); ssq += __shfl_xor(ssq, 8); ssq += __shfl_xor(ssq, 16);
            const float rstd = rsqrtf(ssq * (1.f / 256.f) + GLA_EPS);
            v4u w;
            w.x = cvtpk(o[0] * rstd * gg0.x * silu(bflo(ug.x)), o[1] * rstd * gg0.y * silu(bfhi(ug.x)));
            w.y = cvtpk(o[2] * rstd * gg0.z * silu(bflo(ug.y)), o[3] * rstd * gg0.w * silu(bfhi(ug.y)));
            w.z = cvtpk(o[4] * rstd * gg1.x * silu(bflo(ug.z)), o[5] * rstd * gg1.y * silu(bfhi(ug.z)));
            w.w = cvtpk(o[6] * rstd * gg1.z * silu(bflo(ug.w)), o[7] * rstd * gg1.w * silu(bfhi(ug.w)));
            *(v4u*)(mix + (size_t)row * DM + h * 256 + 8 * l32) = w;
        }
        {
            const v4u u1 = __builtin_nontemporal_load((const v4u*)(obuf + (size_t)row * 1024 + hd * 256 + 8 * l16)), u2 = __builtin_nontemporal_load((const v4u*)(obuf + (size_t)row * 1024 + hd * 256 + 128 + 8 * l16));
            const v4u ug = __builtin_nontemporal_load((const v4u*)(proj + (size_t)row * PJ + C_DG + hd * 128 + 8 * l16));
            float d[8];
            d[0] = bflo(u1.x) - lam * bflo(u2.x); d[1] = bfhi(u1.x) - lam * bfhi(u2.x); d[2] = bflo(u1.y) - lam * bflo(u2.y); d[3] = bfhi(u1.y) - lam * bfhi(u2.y);
            d[4] = bflo(u1.z) - lam * bflo(u2.z); d[5] = bfhi(u1.z) - lam * bfhi(u2.z); d[6] = bflo(u1.w) - lam * bflo(u2.w); d[7] = bfhi(u1.w) - lam * bfhi(u2.w);
            float ssq = (d[0] * d[0] + d[1] * d[1]) + (d[2] * d[2] + d[3] * d[3]) + (d[4] * d[4] + d[5] * d[5]) + (d[6] * d[6] + d[7] * d[7]);
            ssq += __shfl_xor(ssq, 1); ssq += __shfl_xor(ssq, 2); ssq += __shfl_xor(ssq, 4); ssq += __shfl_xor(ssq, 8);
            const float rstd = rsqrtf(ssq * (1.f / 128.f) + DIFF_EPS);
            v4u w;
            w.x = cvtpk(d[0] * rstd * dg0.x * silu(bflo(ug.x)), d[1] * rstd * dg0.y * silu(bfhi(ug.x)));
            w.y = cvtpk(d[2] * rstd * dg0.z * silu(bflo(ug.y)), d[3] * rstd * dg0.w * silu(bfhi(ug.y)));
            w.z = cvtpk(d[4] * rstd * dg1.x * silu(bflo(ug.z)), d[5] * rstd * dg1.y * silu(bfhi(ug.z)));
            w.w = cvtpk(d[6] * rstd * dg1.z * silu(bflo(ug.w)), d[7] * rstd * dg1.w * silu(bfhi(ug.w)));
            *(v4u*)(mix + (size_t)row * DM + 1024 + hd * 128 + 8 * l16) = w;
        }
    }
}
DI void ln_pass(const Args& a, int bx, int G, int wv) {
    const int tid = fresh_tid(wv), lane = tid & 63, gw = bx * NWAVES + __builtin_amdgcn_readfirstlane(tid >> 6), NGW = G * NWAVES;
    const bf16* ob = (const bf16*)(a.ws + WS_OUTB);
    for (int row = gw; row < M; row += NGW) {
        const f32x4* xr = (const f32x4*)(a.x + (size_t)row * DM) + lane;
        const v2u* orow = (const v2u*)(ob + (size_t)row * DM) + lane;
        f32x4 v[8]; float s = 0.f;
#pragma unroll
        for (int j = 0; j < 8; ++j) { const f32x4 xv = __builtin_nontemporal_load(xr + 64 * j); const v2u o = __builtin_nontemporal_load(orow + 64 * j);
            v[j].x = xv.x * ALPHA + bflo(o.x); v[j].y = xv.y * ALPHA + bfhi(o.x); v[j].z = xv.z * ALPHA + bflo(o.y); v[j].w = xv.w * ALPHA + bfhi(o.y);
            s += (v[j].x + v[j].y) + (v[j].z + v[j].w); }
        const float mean = wave_sum(s) * (1.f / DM); float s2 = 0.f;
#pragma unroll
        for (int j = 0; j < 8; ++j) { v[j] = v[j] - mean; s2 += (v[j].x * v[j].x + v[j].y * v[j].y) + (v[j].z * v[j].z + v[j].w * v[j].w); }
        const float rstd = rsqrtf(wave_sum(s2) * (1.f / DM) + LN_EPS);
        f32x4* outr = (f32x4*)(a.out + (size_t)row * DM) + lane;
#pragma unroll
        for (int j = 0; j < 8; ++j) __builtin_nontemporal_store(v[j] * rstd * ((const f32x4*)a.ln_g)[64 * j + lane] + ((const f32x4*)a.ln_b)[64 * j + lane], outr + 64 * j);
    }
}

#define XB_TMO      128
#define XB_XCNT(j)  (256  + 64 * (j))
#define XB_XSUB(j)  (1280 + 64 * (j))
#define XB_XGEN(j)  (2304 + 64 * (j))
#define XB_TOP      3328
#define XB_TOPGEN   3392
#define XCD_BAR_WORDS 3456
#define XB_SPIN_CAP (1u << 18)

__device__ __forceinline__ unsigned xb_ld(unsigned* p)              { return __hip_atomic_load(p, __ATOMIC_RELAXED, __HIP_MEMORY_SCOPE_AGENT); }
__device__ __forceinline__ unsigned xb_add(unsigned* p, unsigned v) { return __hip_atomic_fetch_add(p, v, __ATOMIC_RELAXED, __HIP_MEMORY_SCOPE_AGENT); }
__device__ __forceinline__ unsigned xb_xcc_id() { return (unsigned)__builtin_amdgcn_s_getreg((3 << 11) | 20) & 0xFu; }
#define XB_SPIN(cond, bar) do { unsigned _sp = 0; while (cond) { __builtin_amdgcn_s_sleep(1); \
    if ((++_sp & 255u) == 0u) { if (xb_ld(&(bar)[XB_TMO])) break; if (_sp > XB_SPIN_CAP) { atomicAdd(&(bar)[XB_TMO], 1u); break; } } } } while (0)

struct XcdBarrier {
    unsigned* bar; unsigned x;
    volatile LAS unsigned* st;
};

__device__ __forceinline__ XcdBarrier xcd_barrier_post(unsigned* bar, volatile LAS unsigned* st, bool lead) {
    XcdBarrier b; b.bar = bar; b.x = xb_xcc_id(); b.st = st;
    if (lead) (void)xb_add(&bar[XB_XCNT(b.x)], 1u);
    return b;
}
__device__ __forceinline__ void xcd_barrier_complete(unsigned* bar, unsigned x, unsigned& nloc, unsigned& nx) {
    const unsigned G = gridDim.x * gridDim.y * gridDim.z;
    unsigned sum, cnt, mine, sp = 0u;
    for (;;) {
        sum = 0u; cnt = 0u; mine = 0u;
#pragma unroll
        for (unsigned j = 0; j < 16; ++j) { const unsigned c = xb_ld(&bar[XB_XCNT(j)]); sum += c; cnt += (c > 0u) ? 1u : 0u; mine = (j == x) ? c : mine; }
        if (sum == G) break;
        __builtin_amdgcn_s_sleep(1);
        if ((++sp & 255u) == 0u) { if (xb_ld(&bar[XB_TMO])) break; if (sp > XB_SPIN_CAP) { atomicAdd(&bar[XB_TMO], 1u); break; } }
    }
    nloc = mine > 0u ? mine : 1u; nx = cnt > 0u ? cnt : 1u;
}

__device__ __forceinline__ void xcd_barrier(const XcdBarrier& b, bool lead) {
    asm volatile("s_waitcnt vmcnt(0)" ::: "memory");
    __syncthreads();
    if (lead) {
        unsigned* bar = b.bar;
        __builtin_amdgcn_s_waitcnt(0);
        unsigned nloc = b.st[0], nx = b.st[1];
        if (nloc == 0u) { xcd_barrier_complete(bar, b.x, nloc, nx); b.st[0] = nloc; b.st[1] = nx; }
        const unsigned old = xb_add(&bar[XB_XSUB(b.x)], 1u);
        const unsigned gen = old / nloc;
        if (old + 1u == (gen + 1u) * nloc) {
            __builtin_amdgcn_fence(__ATOMIC_RELEASE, "agent");
            asm volatile("s_waitcnt vmcnt(0)" ::: "memory");
            const unsigned og = xb_add(&bar[XB_TOP], 1u);
            const unsigned tg = og / nx;
            if (og + 1u == (tg + 1u) * nx) xb_add(&bar[XB_TOPGEN], 1u);
            else XB_SPIN(xb_ld(&bar[XB_TOPGEN]) == tg, bar);
            __builtin_amdgcn_fence(__ATOMIC_ACQUIRE, "agent");
            xb_add(&bar[XB_XGEN(b.x)], 1u);
            asm volatile("s_waitcnt vmcnt(0)" ::: "memory");
        } else {
            XB_SPIN(xb_ld(&bar[XB_XGEN(b.x)]) == gen, bar);
            __builtin_amdgcn_fence(__ATOMIC_ACQUIRE, "agent");
            asm volatile("s_waitcnt vmcnt(0)" ::: "memory");
        }
    }
    __syncthreads();
}

#ifndef REP0
#define REP0 1
#endif
#ifndef REP1
#define REP1 1
#endif
#ifndef REP2
#define REP2 1
#endif
#ifndef REPM
#define REPM 1
#endif
#ifndef REPB
#define REPB 0
#endif
#ifndef REPA
#define REPA 1
#endif
#ifndef REPC
#define REPC 1
#endif
#ifndef REP4
#define REP4 1
#endif
#ifndef REP5
#define REP5 1
#endif
#ifndef REP6
#define REP6 1
#endif
constexpr int N_DIFF_UNITS = 2 * 8 * 64, N_MEM_UNITS = 2 * 4 * 64, N_UNITS = N_DIFF_UNITS + N_MEM_UNITS;
__global__ void __launch_bounds__(NWAVES * 64, 2) fwd_mega(Args a) {
    extern __shared__ __attribute__((aligned(16))) unsigned char lds[];
    LAS unsigned char* L = (LAS unsigned char*)lds;
    const int bx = blockIdx.x, G = gridDim.x;
    const int wv = __builtin_amdgcn_readfirstlane((int)threadIdx.x >> 6);
    unsigned char* ws = a.ws;
    const int lo = a.ph_lo, hi = a.ph_hi;
#define IN(k) (lo <= (k) && (k) < hi)
    volatile LAS unsigned* MISC = (volatile LAS unsigned*)(L + MISC_OFF);
    { const int t0 = fresh_tid(wv); if (t0 < 32) MISC[t0] = 0u; }
    __syncthreads();
    const XcdBarrier xbar = xcd_barrier_post((unsigned*)(ws + WS_CTL) + 1024, MISC + 8, a.coop && fresh_tid(wv) == 0);
    if (a.pad == 0x5eed) cg::this_grid().sync();
#define SEAM(k) do { if (IN(k) && IN((k) + 1)) xcd_barrier(xbar, fresh_tid(wv) == 0); } while (0)
    if (IN(0)) { for (int rep = 0; rep < REP0; ++rep) p0_prologue(a, L, bx, G, wv); }
    SEAM(0);
    if (IN(1)) for (int rep = 0; rep < REP1; ++rep) {
        { pg8::Gemm g{(const pg8::bf16_t*)(ws + WS_XB), (const pg8::bf16_t*)(ws + WS_WIN_T), M, PJ, DM}; pg8::StaticOrder S; S.init(M, PJ, G, bx);
          pg8::EpiProj E{(pg8::bf16_t*)(ws + WS_PROJ), (const float*)(ws + WS_CS)};
          pg8::gemm_phase<pg8::EpiProj, pg8::StaticOrder, PG8_ALIGN, PG8_SP2>(L, g, S, E, fresh_tid(wv)); }
    }
    SEAM(1);
    if (IN(2)) {
        for (int rep = 0; rep < REP2; ++rep) for (int u = bx; u < 2048; u += G)
            gla_pre(u, (const bf16*)(ws + WS_PROJ), (const float*)(ws + WS_GLR), a.w_gk_up, a.b_gk_up, (bf16*)(ws + WS_QF), (bf16*)(ws + WS_KF), (bf16*)(ws + WS_VF), (float*)(ws + WS_AL), (bf16*)(ws + WS_OI), L, wv);
    }
    SEAM(2);
    if (IN(3)) {
        unsigned* ctr = (unsigned*)(ws + WS_CTL);
        if (bx < 8) {
            { pg8::Gemm g{(const pg8::bf16_t*)(ws + WS_MEMB), (const pg8::bf16_t*)(ws + WS_WMKV_T), BATCH * NMEM, 1024, DM}; pg8::StaticOrder S; S.init(BATCH * NMEM, 1024, G, bx);
              pg8::EpiMkv E{(pg8::bf16_t*)(ws + WS_MK), (pg8::bf16_t*)(ws + WS_MVT)};
              pg8::gemm_phase<pg8::EpiMkv, pg8::StaticOrder, PG8_ALIGN, PG8_SP2>(L, g, S, E, fresh_tid(wv)); }
            __threadfence();
            __syncthreads();
            if (fresh_tid(wv) == 0) __hip_atomic_fetch_add(ctr + 128, 1u, __ATOMIC_RELEASE, __HIP_MEMORY_SCOPE_AGENT);
        }
        if (bx < 16) for (int rep = 0; rep < REPC; ++rep) gla_chain_wg(bx >> 3, (bx >> 1) & 3, bx & 1, (const bf16*)(ws + WS_QF), (const bf16*)(ws + WS_KF), (const bf16*)(ws + WS_VF), (const float*)(ws + WS_AL), (bf16*)(ws + WS_OX), L, wv);
        for (int rep = 0; rep < REPA; ++rep) {
            const int myq = (int)(xb_xcc_id() & 7u);
            for (int qi = 0; qi < 8; ++qi) {
                const int q = (myq + qi) & 7;
                unsigned* head = ctr + 4608 + 512 * rep + 64 * q;
                for (;;) {
                    __syncthreads();
                    if (fresh_tid(wv) == 0) MISC[0] = atomicAdd(head, 1u);
                    __syncthreads();
                    const int j = (int)MISC[0];
                    if (j >= 128) break;
                    const int qb = 63 - (j >> 1), b = j & 1, hc = q, h = hc >> 1;
                    const attn_body::bf16* P = (const attn_body::bf16*)(ws + WS_PROJ);
                    attn_body::attn_unit<8>(fresh_tid(wv), b, qb, P + C_DQ + hc * 64, P + C_DK + hc * 64, P + C_DV + h * 128,
                                            (attn_body::bf16*)(ws + WS_OBUF) + hc * 128, (char*)lds);
                }
            }
        }
        if (fresh_tid(wv) == 0) {
            unsigned sp = 0u;
            while (__hip_atomic_load(ctr + 128, __ATOMIC_ACQUIRE, __HIP_MEMORY_SCOPE_AGENT) < 8u) { __builtin_amdgcn_s_sleep(8); if (++sp > (1u << 22)) break; }
        }
        __syncthreads();
        __builtin_amdgcn_fence(__ATOMIC_ACQUIRE, "agent");
        for (int rep = 0; rep < REPM; ++rep) for (;;) {
            __syncthreads();
            if (fresh_tid(wv) == 0) MISC[0] = atomicAdd(ctr + 64 + 320 * rep, 1u);
            __syncthreads();
            const int u = (int)MISC[0];
            if (u >= N_MEM_UNITS) break;
            mem_unit(u >> 8, (u >> 6) & 3, u & 63, (const bf16*)(ws + WS_PROJ), (const bf16*)(ws + WS_MK), (const bf16*)(ws + WS_MVT), (bf16*)(ws + WS_MIX), L, wv);
        }
    }
    SEAM(3);
    if (IN(4)) for (int rep = 0; rep < REP4; ++rep) combine_pass(a, bx, G, wv);
    SEAM(4);
    if (IN(5)) for (int rep = 0; rep < REP5; ++rep) {
        pg8::Gemm g{(const pg8::bf16_t*)(ws + WS_MIX), (const pg8::bf16_t*)(ws + WS_WOUT_T), M, DM, DM}; pg8::StaticOrder S; S.init(M, DM, G, bx);
        pg8::EpiOutB E{(pg8::bf16_t*)(ws + WS_OUTB)};
        pg8::gemm_phase<pg8::EpiOutB, pg8::StaticOrder, PG8_ALIGN, PG8_SP2>(L, g, S, E, fresh_tid(wv));
    }
    SEAM(5);
    for (int rep = 0; rep < REPB; ++rep) xcd_barrier(xbar, fresh_tid(wv) == 0);
    if (IN(6)) for (int rep = 0; rep < REP6; ++rep) ln_pass(a, bx, G, wv);
#undef IN
#undef SEAM
}

#ifndef MK_N_LAUNCHES
#define MK_N_LAUNCHES 1
#endif
extern "C" void kernel_launch(void* const* d_in, const int* in_sizes, int n_in, void* d_out, int out_size, void* d_ws, size_t ws_size, hipStream_t stream) {
    static int grid = 0;
    if (grid == 0) {
        if (n_in != 16 || in_sizes[0] != M * DM || out_size != M * DM || ws_size < WS_END) { fprintf(stderr, "kernel_launch: unexpected shapes (n_in %d, in0 %d, out %d, ws %zu)\n", n_in, n_in > 0 ? in_sizes[0] : -1, out_size, ws_size); grid = -1; return; }
        int dev = 0, cus = 0, per_cu = 0;
        if (hipGetDevice(&dev) != hipSuccess || hipDeviceGetAttribute(&cus, hipDeviceAttributeMultiprocessorCount, dev) != hipSuccess) { grid = -1; return; }
        if (hipFuncSetAttribute((const void*)fwd_mega, hipFuncAttributeMaxDynamicSharedMemorySize, LDS_BYTES) != hipSuccess) { fprintf(stderr, "kernel_launch: hipFuncSetAttribute failed\n"); grid = -1; return; }
        if (hipOccupancyMaxActiveBlocksPerMultiprocessor(&per_cu, (const void*)fwd_mega, NWAVES * 64, LDS_BYTES) != hipSuccess || per_cu < 1) { fprintf(stderr, "kernel_launch: occupancy query says %d\n", per_cu); per_cu = 1; }
        (void)hipGetLastError();
        grid = cus;
    }
    if (grid < 0) return;
    (void)hipMemsetAsync((char*)d_ws + WS_CTL, 0, CTL_ZERO_BYTES, stream);
    Args a{};
    a.x = (const float*)d_in[0]; a.mem = (const float*)d_in[1]; a.pos = (const int*)d_in[2]; a.w_in = (const float*)d_in[3]; a.w_gk_up = (const float*)d_in[4]; a.b_gk_up = (const float*)d_in[5];
    a.gla_g = (const float*)d_in[6]; a.lq1 = (const float*)d_in[7]; a.lk1 = (const float*)d_in[8]; a.lq2 = (const float*)d_in[9]; a.lk2 = (const float*)d_in[10]; a.diff_g = (const float*)d_in[11];
    a.w_mkv = (const float*)d_in[12]; a.w_out = (const float*)d_in[13]; a.ln_g = (const float*)d_in[14]; a.ln_b = (const float*)d_in[15];
    a.out = (float*)d_out; a.ws = (unsigned char*)d_ws;
    for (int i = 0; i < 8; ++i) a.inv_freq[i] = (float)pow(500000.0, -(double)i / 8.0);
    a.pad = 0;
#if MK_N_LAUNCHES == 1
    a.ph_lo = 0; a.ph_hi = 7; a.coop = 1;
    void* args[] = {&a};
    hipError_t e = hipLaunchCooperativeKernel((const void*)fwd_mega, dim3(grid), dim3(NWAVES * 64), args, LDS_BYTES, stream);
    if (e != hipSuccess) fprintf(stderr, "kernel_launch: cooperative launch failed: %s (grid %d)\n", hipGetErrorString(e), grid);
#else
    for (int p = 0; p < 7; ++p) {
        a.ph_lo = p; a.ph_hi = p + 1; a.coop = 0;
        hipLaunchKernelGGL(fwd_mega, dim3(grid), dim3(NWAVES * 64), LDS_BYTES, stream, a);
    }
#endif
}
```
